# Optimizing an MI355X kernel written in HIP

```python
import math
import jax, jax.numpy as jnp
from jax import lax
import numpy as np

D_MODEL = 1024
BATCH = 2
SEQ = 16384
DEPTH = 4

GRID_W = 64
CTX_LEN = 256
D_MIX = D_MODEL
F_GROUPS = 4
F_GROUP_DIM = 64
F_WIDTH = F_GROUPS * F_GROUP_DIM
MLA_HEADS = 8
QK_NOPE_DIM = 64
QK_ROPE_DIM = 32
V_HEAD_DIM = 64
MLA_WIDTH = MLA_HEADS * V_HEAD_DIM
Q_LORA_RANK = 256
KV_LORA_RANK = 128
CONV_WIDTH = D_MIX - F_WIDTH - MLA_WIDTH
CONV_KERNEL = 31
D_IN = F_WIDTH + Q_LORA_RANK + KV_LORA_RANK + QK_ROPE_DIM + 2 * CONV_WIDTH
SPLITS = (F_WIDTH,
          F_WIDTH + Q_LORA_RANK,
          F_WIDTH + Q_LORA_RANK + KV_LORA_RANK,
          F_WIDTH + Q_LORA_RANK + KV_LORA_RANK + QK_ROPE_DIM)
D_FF = 4 * D_MODEL
N_MOD = 6
ROPE_BASE = 10000.0
ROPE_AXIS_DIM = QK_ROPE_DIM // 2
ATTN_SCALE = (QK_NOPE_DIM + QK_ROPE_DIM) ** -0.5
Q_BLOCK = 128
EPS = 1e-6

kernel_name = "hybrid_fourier_mla_conformer_dit"


def rms_norm(x, g):
    xf = x.astype(jnp.float32)
    y = xf * lax.rsqrt(jnp.mean(jnp.square(xf), axis=-1, keepdims=True) + EPS)
    return (y * g.astype(jnp.float32)).astype(x.dtype)


def layer_norm(x, g, b):
    xf = x.astype(jnp.float32)
    mu = jnp.mean(xf, axis=-1, keepdims=True)
    xc = xf - mu
    var = jnp.mean(jnp.square(xc), axis=-1, keepdims=True)
    y = xc * lax.rsqrt(var + EPS) * g.astype(jnp.float32) + b.astype(jnp.float32)
    return y.astype(x.dtype)


def modulate(h, shift, scale):
    return h * (1 + scale) + shift


def axial_rope_angles(n_tokens):
    rows = n_tokens // GRID_W
    t = jnp.arange(rows * GRID_W)
    row = (t // GRID_W).astype(jnp.float32)
    col = (t % GRID_W).astype(jnp.float32)
    inv = ROPE_BASE ** (-jnp.arange(0, ROPE_AXIS_DIM, 2, dtype=jnp.float32) / ROPE_AXIS_DIM)
    ang = jnp.concatenate([row[:, None] * inv, col[:, None] * inv], axis=-1)
    return jnp.cos(ang), jnp.sin(ang)


def apply_rope(x, cos, sin):
    half = QK_ROPE_DIM // 2
    x1, x2 = x[..., :half], x[..., half:]
    cos = cos.astype(x.dtype)
    sin = sin.astype(x.dtype)
    return jnp.concatenate([x1 * cos - x2 * sin, x1 * sin + x2 * cos], axis=-1)


def fourier_mix(zf, w_f):
    B, N, _ = zf.shape
    u = zf.reshape(B, N, F_GROUPS, F_GROUP_DIM).astype(jnp.float32)
    y = jnp.fft.fftn(u, axes=(1, 3), norm="ortho").real
    return y.reshape(B, N, F_WIDTH).astype(zf.dtype) @ w_f


def conformer_conv(zg, w_dw, b_dw, ln_g, ln_b, w_pw2):
    a, g = jnp.split(zg, 2, axis=-1)
    u = a * jax.nn.sigmoid(g)
    pad = CONV_KERNEL // 2
    u = lax.conv_general_dilated(u, w_dw[:, None, :], window_strides=(1,),
                                 padding=((pad, pad),),
                                 dimension_numbers=("NWC", "WIO", "NWC"),
                                 feature_group_count=CONV_WIDTH) + b_dw
    u = jax.nn.silu(layer_norm(u, ln_g, ln_b))
    return u @ w_pw2


def mla_queries(cq, q_g, w_uq):
    B, N, _ = cq.shape
    q = (rms_norm(cq, q_g) @ w_uq).reshape(B, N, MLA_HEADS, QK_NOPE_DIM + QK_ROPE_DIM)
    return q[..., :QK_NOPE_DIM], q[..., QK_NOPE_DIM:]


def mla_keys_values(ckv, kv_g, w_ukv):
    B, N, _ = ckv.shape
    kv = (rms_norm(ckv, kv_g) @ w_ukv).reshape(B, N, MLA_HEADS, QK_NOPE_DIM + V_HEAD_DIM)
    return kv[..., :QK_NOPE_DIM], kv[..., QK_NOPE_DIM:]


def mla_attend(qn, qr, kn, kr, v):
    s = jnp.einsum("bqhd,bkhd->bhqk", qn, kn) + jnp.einsum("bqhr,bkr->bhqk", qr, kr)
    p = jax.nn.softmax(s.astype(jnp.float32) * ATTN_SCALE, axis=-1).astype(v.dtype)
    return jnp.einsum("bhqk,bkhd->bqhd", p, v)


def blocked_mla_attend(qn, qr, kn, kr, v):
    B, N, H, _ = qn.shape
    nblk = N // Q_BLOCK

    def to_blocks(q):
        return q.reshape(B, nblk, Q_BLOCK, H, q.shape[-1]).transpose(1, 0, 2, 3, 4)

    out = lax.map(lambda qs: mla_attend(qs[0], qs[1], kn, kr, v), (to_blocks(qn), to_blocks(qr)))
    return out.transpose(1, 0, 2, 3, 4).reshape(B, N, H * V_HEAD_DIM)


def setup_inputs(seed: int = 0) -> dict:
    key = jax.random.key(seed)
    ks = jax.random.split(key, 24)
    f32 = jnp.float32
    L = DEPTH

    def nrm(k, shape, scale):
        return jax.random.normal(k, shape, f32) * scale

    return {
        "x": nrm(ks[0], (BATCH, SEQ, D_MODEL), 1.0),
        "c": nrm(ks[1], (BATCH, D_MODEL), 1.0),
        "ctx": nrm(ks[2], (BATCH, CTX_LEN, D_MODEL), 1.0),
        "c_ctx": nrm(ks[3], (D_MODEL,), 1.0),
        "w_mod": nrm(ks[4], (L, D_MODEL, N_MOD * D_MODEL), 0.5 * D_MODEL ** -0.5),
        "b_mod": nrm(ks[5], (L, N_MOD * D_MODEL), 0.01),
        "norm1_g": 1.0 + nrm(ks[6], (L, D_MODEL), 0.05),
        "w_in": nrm(ks[7], (L, D_MODEL, D_IN), D_MODEL ** -0.5),
        "q_norm_g": 1.0 + nrm(ks[8], (L, Q_LORA_RANK), 0.05),
        "w_uq": nrm(ks[9], (L, Q_LORA_RANK, MLA_HEADS * (QK_NOPE_DIM + QK_ROPE_DIM)), Q_LORA_RANK ** -0.5),
        "kv_norm_g": 1.0 + nrm(ks[10], (L, KV_LORA_RANK), 0.05),
        "w_ukv": nrm(ks[11], (L, KV_LORA_RANK, MLA_HEADS * (QK_NOPE_DIM + V_HEAD_DIM)), KV_LORA_RANK ** -0.5),
        "w_fourier": nrm(ks[12], (L, F_WIDTH, F_WIDTH), F_WIDTH ** -0.5),
        "w_dw": nrm(ks[13], (L, CONV_KERNEL, CONV_WIDTH), CONV_KERNEL ** -0.5),
        "b_dw": nrm(ks[14], (L, CONV_WIDTH), 0.01),
        "conv_ln_g": 1.0 + nrm(ks[15], (L, CONV_WIDTH), 0.05),
        "conv_ln_b": nrm(ks[16], (L, CONV_WIDTH), 0.01),
        "w_pw2": nrm(ks[17], (L, CONV_WIDTH, CONV_WIDTH), CONV_WIDTH ** -0.5),
        "w_o": nrm(ks[18], (L, D_MIX, D_MODEL), D_MIX ** -0.5),
        "norm2_g": 1.0 + nrm(ks[19], (L, D_MODEL), 0.05),
        "w_mlp1": nrm(ks[20], (L, D_MODEL, D_FF), D_MODEL ** -0.5),
        "w_mlp2": nrm(ks[21], (L, D_FF, D_MODEL), D_FF ** -0.5),
        "final_norm_g": 1.0 + nrm(ks[22], (D_MODEL,), 0.05),
    }


def reference(x, c, ctx, c_ctx, w_mod, b_mod, norm1_g, w_in, q_norm_g, w_uq, kv_norm_g, w_ukv,
              w_fourier, w_dw, b_dw, conv_ln_g, conv_ln_b, w_pw2, w_o, norm2_g, w_mlp1, w_mlp2,
              final_norm_g):
    B, S, D = x.shape
    cos, sin = axial_rope_angles(S)
    silu_c = jax.nn.silu(c)
    silu_cc = jax.nn.silu(c_ctx)

    def mixer_rest(zf, zg, attn_out, l):
        y_f = fourier_mix(zf, w_fourier[l])
        y_c = conformer_conv(zg, w_dw[l], b_dw[l], conv_ln_g[l], conv_ln_b[l], w_pw2[l])
        return jnp.concatenate([y_f, attn_out, y_c], axis=-1) @ w_o[l]

    def channel_mlp(h, l):
        return jnp.square(jax.nn.relu(h @ w_mlp1[l])) @ w_mlp2[l]

    for l in range(DEPTH):
        last = l == DEPTH - 1
        mx = jnp.split((silu_c @ w_mod[l] + b_mod[l])[:, None, :], N_MOD, axis=-1)
        mc = jnp.split(silu_cc @ w_mod[l] + b_mod[l], N_MOD, axis=-1)

        zx = modulate(rms_norm(x, norm1_g[l]), mx[0], mx[1]) @ w_in[l]
        zc = modulate(rms_norm(ctx, norm1_g[l]), mc[0], mc[1]) @ w_in[l]
        fx, cqx, ckvx, krx, gx = jnp.split(zx, SPLITS, axis=-1)
        fc, cqc, ckvc, krc, gc = jnp.split(zc, SPLITS, axis=-1)

        kn_c, v_c = mla_keys_values(ckvc, kv_norm_g[l], w_ukv[l])
        kn_x, v_x = mla_keys_values(ckvx, kv_norm_g[l], w_ukv[l])
        kr_x = apply_rope(krx, cos, sin)
        qn_x, qr_x = mla_queries(cqx, q_norm_g[l], w_uq[l])
        qr_x = apply_rope(qr_x, cos[:, None, :], sin[:, None, :])

        kn_all = jnp.concatenate([kn_c, kn_x], axis=1)
        kr_all = jnp.concatenate([krc, kr_x], axis=1)
        v_all = jnp.concatenate([v_c, v_x], axis=1)
        attn_x = blocked_mla_attend(qn_x, qr_x, kn_all, kr_all, v_all)

        if not last:
            qn_c, qr_c = mla_queries(cqc, q_norm_g[l], w_uq[l])
            attn_c = mla_attend(qn_c, qr_c, kn_c, krc, v_c).reshape(B, ctx.shape[1], MLA_WIDTH)
            ctx = ctx + mc[2] * mixer_rest(fc, gc, attn_c, l)
            hc = modulate(rms_norm(ctx, norm2_g[l]), mc[3], mc[4])
            ctx = ctx + mc[5] * channel_mlp(hc, l)

        x = x + mx[2] * mixer_rest(fx, gx, attn_x, l)
        hx = modulate(rms_norm(x, norm2_g[l]), mx[3], mx[4])
        x = x + mx[5] * channel_mlp(hx, l)

    return rms_norm(x, final_norm_g)
```

```cpp
#include <hip/hip_runtime.h>
#include <hip/hip_cooperative_groups.h>
#include <cstdio>
#include <cstdint>
namespace cg = cooperative_groups;

#ifndef MK_MULTI
#define MK_MULTI 0
#endif

typedef unsigned short u16;
using bf16x8 = __attribute__((ext_vector_type(8))) short;
using f32x16 = __attribute__((ext_vector_type(16))) float;
using u32x4  = __attribute__((ext_vector_type(4))) unsigned;
using u32x2  = __attribute__((ext_vector_type(2))) unsigned;
#define DI __device__ __forceinline__
#define MFMA(a, b, c) __builtin_amdgcn_mfma_f32_32x32x16_bf16((a), (b), (c), 0, 0, 0)

constexpr int DM = 1024, NLAT = 32768, NCTX = 512, NT = NLAT + NCTX, SEQ = 16384, CTXL = 256, NLAYER = 4;
constexpr int ZW = 1440, NINP = 1536, DFF = 4096, NKEYS = SEQ + CTXL, NH = 8;
constexpr int MT = NT / 128;
constexpr float EPS = 1e-6f;
constexpr float QSCALE = 0.10206207261596575f * 1.4426950408889634f;

constexpr size_t al256(size_t x) { return (x + 255) / 256 * 256; }
constexpr size_t SZ_WIN = (size_t)NLAYER * NINP * DM * 2, SZ_WUQ = (size_t)NLAYER * 768 * 256 * 2, SZ_WUKV = (size_t)NLAYER * 1024 * 128 * 2;
constexpr size_t SZ_WO = (size_t)NLAYER * DM * DM * 2, SZ_W1 = (size_t)NLAYER * DFF * DM * 2, SZ_W2 = SZ_W1;
constexpr size_t OFF_WIN = 0, OFF_WUQ = OFF_WIN + SZ_WIN, OFF_WUKV = OFF_WUQ + SZ_WUQ, OFF_WO = OFF_WUKV + SZ_WUKV;
constexpr size_t OFF_W1 = OFF_WO + SZ_WO, OFF_W2 = OFF_W1 + SZ_W1, OFF_MOD = OFF_W2 + SZ_W2;
constexpr size_t OFF_A1T = OFF_MOD + al256((size_t)NLAYER * 3 * 6144 * 4);
constexpr size_t OFF_A2T = OFF_A1T + 256 * 256 * 2, OFF_A3T = OFF_A2T + 128 * 256 * 2, OFF_TW = OFF_A3T + 256 * 512 * 2;
constexpr size_t OFF_ROPE = OFF_TW + 16384 * 8, OFF_XRC = OFF_ROPE + 256 * 8 * 8, OFF_H = OFF_XRC + (size_t)NCTX * DM * 4;
constexpr size_t OFF_UNI = OFF_H + (size_t)NT * DM * 2;
constexpr size_t OFF_Z = OFF_UNI, OFF_Q = OFF_Z + (size_t)NT * ZW * 2, OFF_K = OFF_Q + (size_t)NT * 768 * 2;
constexpr size_t OFF_VT = OFF_K + (size_t)2 * NH * NKEYS * 96 * 2, OFF_CAT = OFF_VT + (size_t)2 * NH * 64 * NKEYS * 2;
constexpr size_t OFF_Y = OFF_CAT + (size_t)NT * DM * 2, UNI_END = OFF_Y + (size_t)2 * SEQ * 512 * 2;
constexpr size_t OFF_A1 = OFF_UNI, A1_END = OFF_A1 + (size_t)NT * DFF * 2;
constexpr size_t WS_NEED = UNI_END > A1_END ? UNI_END : A1_END;
constexpr int LDS_BYTES = 73728;

struct Params {
  const float *x, *c, *ctx, *c_ctx, *w_mod, *b_mod, *norm1_g, *w_in, *q_norm_g, *w_uq, *kv_norm_g, *w_ukv, *w_fourier, *w_dw, *b_dw,
      *conv_ln_g, *conv_ln_b, *w_pw2, *w_o, *norm2_g, *w_mlp1, *w_mlp2, *final_norm_g;
  float* out;
  char* ws;
};

DI int ltid() { int t = threadIdx.x; asm volatile("" : "+v"(t)); return t; }
DI int crow(int reg, int h) { return (reg & 3) + 8 * (reg >> 2) + 4 * h; }
DI unsigned cvtpk(float lo, float hi) { unsigned r; asm("v_cvt_pk_bf16_f32 %0, %1, %2" : "=v"(r) : "v"(lo), "v"(hi)); return r; }
DI u16 f2bf(float x) { return (u16)(cvtpk(x, 0.f) & 0xffffu); }
DI float bf2f(u16 v) { return __uint_as_float(((unsigned)v) << 16); }
DI u32x2 pack4(float a, float b, float c, float d) { u32x2 r; r[0] = cvtpk(a, b); r[1] = cvtpk(c, d); return r; }
DI float wave_sum(float v) {
#pragma unroll
  for (int o = 32; o; o >>= 1) v += __shfl_xor(v, o, 64);
  return v;
}
DI float swap_max(float v) {
  auto rr = __builtin_amdgcn_permlane32_swap(__float_as_uint(v), __float_as_uint(v), false, false);
  return fmaxf(__uint_as_float(rr[0]), __uint_as_float(rr[1]));
}
DI float swap_sum(float v) {
  auto rr = __builtin_amdgcn_permlane32_swap(__float_as_uint(v), __float_as_uint(v), false, false);
  return __uint_as_float(rr[0]) + __uint_as_float(rr[1]);
}
DI float sigmoidf_(float x) { return 1.f / (1.f + __expf(-x)); }
DI float* xrow(const Params& p, int row) { return row < NLAT ? p.out + (size_t)row * DM : (float*)(p.ws + OFF_XRC) + (size_t)(row - NLAT) * DM; }
DI int mod_index(int row) { return row < NLAT ? (row >> 14) : 2; }
DI const float* modp(const Params& p, int l, int mi, int chunk) { return (const float*)(p.ws + OFF_MOD) + ((size_t)(l * 3 + mi) * 6 + chunk) * 1024; }
DI void tok_info(int m, int& b, int& key, bool& lat, int& pos) {
  if (m < NLAT) { b = m >> 14; pos = m & (SEQ - 1); key = CTXL + pos; lat = true; }
  else { int mm = m - NLAT; b = mm >> 8; pos = mm & 255; key = pos; lat = false; }
}
DI int vpos(int key) { return (key & ~12) | ((key & 4) << 1) | ((key & 8) >> 1); }

constexpr int GP = 72, GPB = 136;
template <int BT, bool RMS, class BRow>
DI void gemm128(const u16* __restrict__ A, int lda, BRow brow, int K, char* lds, f32x16 (&acc)[2][2], float (&rinv)[2]) {
  const int tid = ltid(), lane = tid & 63, wave = tid >> 6, r = lane & 31, h = lane >> 5;
  const int wa = wave >> 1, wb = wave & 1;
  u16* As = (u16*)lds;
  u16* Bs = As + 2 * 128 * GP;
  constexpr int BSZ = BT ? 64 * GPB : 128 * GP;
  __syncthreads();
#pragma unroll
  for (int i = 0; i < 2; ++i)
#pragma unroll
    for (int j = 0; j < 2; ++j)
#pragma unroll
      for (int q = 0; q < 16; ++q) acc[i][j][q] = 0.f;
  float ss[4] = {0.f, 0.f, 0.f, 0.f};
  const int KT = K / 64;
  uint4 ra[4], rb[4];
  auto gload = [&](int kt) {
    const int k0 = kt * 64;
#pragma unroll
    for (int i = 0; i < 4; ++i) { int c = tid + 256 * i; int row = c >> 3, kc = (c & 7) * 8; ra[i] = *(const uint4*)(A + (size_t)row * lda + k0 + kc); }
    if (BT == 0) {
#pragma unroll
      for (int i = 0; i < 4; ++i) { int c = tid + 256 * i; int row = c >> 3, kc = (c & 7) * 8; rb[i] = *(const uint4*)(brow(row) + k0 + kc); }
    } else {
#pragma unroll
      for (int i = 0; i < 4; ++i) { int c = tid + 256 * i; int kr = c >> 4, nc = (c & 15) * 8; rb[i] = *(const uint4*)(brow(k0 + kr) + nc); }
    }
  };
  auto sstore = [&](int buf) {
#pragma unroll
    for (int i = 0; i < 4; ++i) { int c = tid + 256 * i; int row = c >> 3, kc = (c & 7) * 8; *(uint4*)(As + buf * 128 * GP + row * GP + kc) = ra[i]; }
    if (BT == 0) {
#pragma unroll
      for (int i = 0; i < 4; ++i) {
        int c = tid + 256 * i; int row = c >> 3, kc = (c & 7) * 8; *(uint4*)(Bs + buf * BSZ + row * GP + kc) = rb[i];
        if (RMS) {
          unsigned w[4] = {rb[i].x, rb[i].y, rb[i].z, rb[i].w};
#pragma unroll
          for (int q = 0; q < 4; ++q) { float lo = __uint_as_float(w[q] << 16), hi = __uint_as_float(w[q] & 0xffff0000u); ss[i] += lo * lo + hi * hi; }
        }
      }
    } else {
#pragma unroll
      for (int i = 0; i < 4; ++i) { int c = tid + 256 * i; int kr = c >> 4, nc = (c & 15) * 8; *(uint4*)(Bs + buf * BSZ + kr * GPB + nc) = rb[i]; }
    }
  };
  gload(0); sstore(0); __syncthreads();
  for (int kt = 0; kt < KT; ++kt) {
    const int cur = kt & 1;
    if (kt + 1 < KT) gload(kt + 1);
    const u16* Ab = As + cur * 128 * GP + (wa * 64 + r) * GP + 8 * h;
    const u16* Bb = Bs + cur * BSZ;
#pragma unroll
    for (int ks = 0; ks < 4; ++ks) {
      bf16x8 af[2], bfr[2];
#pragma unroll
      for (int i = 0; i < 2; ++i) af[i] = *(const bf16x8*)(Ab + i * 32 * GP + ks * 16);
      if (BT == 0) {
#pragma unroll
        for (int j = 0; j < 2; ++j) bfr[j] = *(const bf16x8*)(Bb + (wb * 64 + j * 32 + r) * GP + ks * 16 + 8 * h);
      } else {
#pragma unroll
        for (int j = 0; j < 2; ++j)
#pragma unroll
          for (int q = 0; q < 8; ++q) bfr[j][q] = (short)Bb[(ks * 16 + 8 * h + q) * GPB + wb * 64 + j * 32 + r];
      }
#pragma unroll
      for (int i = 0; i < 2; ++i)
#pragma unroll
        for (int j = 0; j < 2; ++j) acc[i][j] = MFMA(af[i], bfr[j], acc[i][j]);
    }
    if (kt + 1 < KT) sstore(cur ^ 1);
    __syncthreads();
  }
  rinv[0] = rinv[1] = 1.f;
  if (RMS) {
    float* rs = (float*)lds;
#pragma unroll
    for (int i = 0; i < 4; ++i) {
      float v = ss[i];
      v += __shfl_xor(v, 1, 64); v += __shfl_xor(v, 2, 64); v += __shfl_xor(v, 4, 64);
      if ((tid & 7) == 0) rs[(tid >> 3) + 32 * i] = rsqrtf(v / (float)K + EPS);
    }
    __syncthreads();
    rinv[0] = rs[wb * 64 + r]; rinv[1] = rs[wb * 64 + 32 + r];
  }
}

DI void rope_block(f32x16& v, int h, int pos, const float2* __restrict__ ropetab) {
  const int rowp = pos >> 6, colp = pos & 63;
#pragma unroll
  for (int g = 0; g < 2; ++g)
#pragma unroll
    for (int i = 0; i < 4; ++i) {
      const int f = 8 * g + 4 * h + i;
      const float2 cs = (f < 8) ? ropetab[rowp * 8 + f] : ropetab[colp * 8 + (f - 8)];
      const float x1 = v[4 * g + i], x2 = v[4 * (g + 2) + i];
      v[4 * g + i] = x1 * cs.x - x2 * cs.y;
      v[4 * (g + 2) + i] = x1 * cs.y + x2 * cs.x;
    }
}

DI void prep_transpose_tile(const float* __restrict__ W, int ldn, int k0, int n0, int nlimit, u16* __restrict__ Wt, int ldk, int ndst0, int kdst0,
                            const float* __restrict__ rowscale, char* lds) {
  float* t = (float*)lds;
  const int tid = ltid();
  __syncthreads();
#pragma unroll
  for (int it = 0; it < 16; ++it) {
    int i = (tid >> 6) + 4 * it, j = tid & 63;
    float v = 0.f;
    if (n0 + j < nlimit) v = W[(size_t)(k0 + i) * ldn + n0 + j];
    if (rowscale) v *= rowscale[k0 + i];
    t[i * 65 + j] = v;
  }
  __syncthreads();
#pragma unroll
  for (int it = 0; it < 16; ++it) {
    int j = (tid >> 6) + 4 * it, i = tid & 63;
    if (n0 + j < nlimit) Wt[(size_t)(ndst0 + j) * ldk + kdst0 + i] = f2bf(t[i * 65 + j]);
  }
}

DI void phase_prep(const Params& p, char* lds) {
  const int tid = ltid(), G = gridDim.x, bid = blockIdx.x;
  u16* Win = (u16*)(p.ws + OFF_WIN); u16* Wuq = (u16*)(p.ws + OFF_WUQ); u16* Wukv = (u16*)(p.ws + OFF_WUKV);
  u16* Wo = (u16*)(p.ws + OFF_WO); u16* W1 = (u16*)(p.ws + OFF_W1); u16* W2 = (u16*)(p.ws + OFF_W2);
  {
    const float4* xs = (const float4*)p.x; float4* xd = (float4*)p.out;
    for (size_t i = (size_t)bid * 256 + tid; i < (size_t)NLAT * DM / 4; i += (size_t)G * 256) xd[i] = xs[i];
    const float4* cs = (const float4*)p.ctx; float4* cd = (float4*)(p.ws + OFF_XRC);
    for (size_t i = (size_t)bid * 256 + tid; i < (size_t)NCTX * DM / 4; i += (size_t)G * 256) cd[i] = cs[i];
  }
  {
    u16* A1 = (u16*)(p.ws + OFF_A1T); u16* A2 = (u16*)(p.ws + OFF_A2T); u16* A3 = (u16*)(p.ws + OFF_A3T);
    float2* TW = (float2*)(p.ws + OFF_TW); float2* RP = (float2*)(p.ws + OFF_ROPE);
    for (int e = bid * 256 + tid; e < 256 * 256; e += G * 256) {
      int m = e >> 8, k = e & 255; int ro = (m >> 5) & 1, k1 = (m >> 6) * 32 + (m & 31), ri = k >> 7, n1 = k & 127;
      float ang = (float)((n1 * k1) & 127) / 64.f; float c = cospif(ang), s = sinpif(ang);
      float v = (ro == 0) ? (ri == 0 ? c : s) : (ri == 0 ? -s : c);
      A1[e] = f2bf(v);
    }
    for (int e = bid * 256 + tid; e < 128 * 256; e += G * 256) {
      int k2 = e >> 8, k = e & 255; int ri = k >> 7, n2 = k & 127;
      float ang = (float)((n2 * k2) & 127) / 64.f;
      A2[e] = f2bf(ri ? sinpif(ang) : cospif(ang));
    }
    for (int e = bid * 256 + tid; e < 256 * 512; e += G * 256) {
      int kk = e >> 9, k = e & 511; int ri = k >> 8, n = k & 255;
      float ang = (float)((n * kk) & 255) / 128.f;
      A3[e] = f2bf(ri ? sinpif(ang) : cospif(ang));
    }
    for (int e = bid * 256 + tid; e < 16384; e += G * 256) { float ang = (float)e / 8192.f; TW[e] = make_float2(cospif(ang), sinpif(ang)); }
    for (int e = bid * 256 + tid; e < 256 * 8; e += G * 256) {
      int pos = e >> 3, j = e & 7;
      const float invt[8] = {1.f, 0.31622776601683794f, 0.1f, 0.031622776601683794f, 0.01f, 0.0031622776601683794f, 0.001f, 0.00031622776601683794f};
      float inv = j == 0 ? invt[0] : j == 1 ? invt[1] : j == 2 ? invt[2] : j == 3 ? invt[3] : j == 4 ? invt[4] : j == 5 ? invt[5] : j == 6 ? invt[6] : invt[7];
      float angf = (float)pos * inv;
      double tt = (double)angf * 0.15915494309189535;
      tt -= floor(tt);
      float a2 = (float)(2.0 * tt);
      RP[e] = make_float2(cospif(a2), sinpif(a2));
    }
  }
  {
    float* sl = (float*)lds;
    float* part = sl + 3 * 1024;
    float* modo = (float*)(p.ws + OFF_MOD);
    const int lane = tid & 63, wave = tid >> 6;
    for (int it = bid; it < NLAYER * 96; it += G) {
      const int l = it / 96, cgp = it % 96;
      __syncthreads();
      for (int e = tid; e < 3 * 1024; e += 256) {
        int mi = e >> 10, k = e & 1023; float v = mi < 2 ? p.c[mi * 1024 + k] : p.c_ctx[k];
        sl[e] = v * sigmoidf_(v);
      }
      __syncthreads();
      const int j = cgp * 64 + lane;
      const float* wp = p.w_mod + ((size_t)l * 1024 + wave * 256) * 6144 + j;
      float a0 = 0.f, a1 = 0.f, a2 = 0.f;
#pragma unroll 8
      for (int k = 0; k < 256; ++k) {
        float w = wp[(size_t)k * 6144];
        a0 += sl[wave * 256 + k] * w; a1 += sl[1024 + wave * 256 + k] * w; a2 += sl[2048 + wave * 256 + k] * w;
      }
      part[(wave * 3 + 0) * 64 + lane] = a0; part[(wave * 3 + 1) * 64 + lane] = a1; part[(wave * 3 + 2) * 64 + lane] = a2;
      __syncthreads();
      if (tid < 192) {
        int mi = tid >> 6, ln = tid & 63;
        float s = part[(0 * 3 + mi) * 64 + ln] + part[(1 * 3 + mi) * 64 + ln] + part[(2 * 3 + mi) * 64 + ln] + part[(3 * 3 + mi) * 64 + ln];
        int jj = cgp * 64 + ln;
        modo[(size_t)(l * 3 + mi) * 6144 + jj] = s + p.b_mod[l * 6144 + jj];
      }
    }
  }
  {
    constexpr int T_IN = 16 * 15, T_UQ = 4 * 12, T_UKV = 2 * 16, T_O = 8 * 16, T_1 = 16 * 64, T_2 = 64 * 16;
    constexpr int T_L = T_IN + T_UQ + T_UKV + T_O + T_1 + T_2;
    for (int it = bid; it < NLAYER * T_L; it += G) {
      const int l = it / T_L; int t = it % T_L;
      if (t < T_IN) { int kt = t / 15, nt = t % 15;
        prep_transpose_tile(p.w_in + (size_t)l * DM * 1184, 1184, kt * 64, 256 + nt * 64, 1184, Win + (size_t)l * NINP * DM, DM, 512 + nt * 64, kt * 64, nullptr, lds); continue; }
      t -= T_IN;
      if (t < T_UQ) { int kt = t / 12, nt = t % 12;
        prep_transpose_tile(p.w_uq + (size_t)l * 256 * 768, 768, kt * 64, nt * 64, 768, Wuq + (size_t)l * 768 * 256, 256, nt * 64, kt * 64, p.q_norm_g + l * 256, lds); continue; }
      t -= T_UQ;
      if (t < T_UKV) { int kt = t / 16, nt = t % 16;
        prep_transpose_tile(p.w_ukv + (size_t)l * 128 * 1024, 1024, kt * 64, nt * 64, 1024, Wukv + (size_t)l * 1024 * 128, 128, nt * 64, kt * 64, p.kv_norm_g + l * 128, lds); continue; }
      t -= T_UKV;
      if (t < T_O) { int kt = t / 16, nt = t % 16;
        prep_transpose_tile(p.w_o + (size_t)l * DM * DM, DM, 256 + kt * 64, nt * 64, DM, Wo + (size_t)l * DM * DM, DM, nt * 64, 256 + kt * 64, nullptr, lds); continue; }
      t -= T_O;
      if (t < T_1) { int kt = t / 64, nt = t % 64;
        prep_transpose_tile(p.w_mlp1 + (size_t)l * DM * DFF, DFF, kt * 64, nt * 64, DFF, W1 + (size_t)l * DFF * DM, DM, nt * 64, kt * 64, nullptr, lds); continue; }
      t -= T_1;
      { int kt = t / 16, nt = t % 16;
        prep_transpose_tile(p.w_mlp2 + (size_t)l * DFF * DM, DM, kt * 64, nt * 64, DM, W2 + (size_t)l * DM * DFF, DFF, nt * 64, kt * 64, nullptr, lds); }
    }
  }
  {
    float* Ws = (float*)lds;
    float* ct = Ws + 64 * 65;
    float* st = ct + 64;
    for (int it = bid; it < NLAYER * 4 * 16; it += G) {
      const int l = it >> 6, g = (it >> 4) & 3, kt = it & 15;
      __syncthreads();
      if (tid < 64) { float ang = (float)tid / 32.f; ct[tid] = cospif(ang); st[tid] = sinpif(ang); }
#pragma unroll
      for (int i = 0; i < 16; ++i) { int e = tid + 256 * i; int kk = e >> 6, c = e & 63; Ws[kk * 65 + c] = p.w_in[((size_t)l * DM + kt * 64 + kk) * 1184 + g * 64 + c]; }
      __syncthreads();
      const int kk = tid & 63;
      for (int mm = 0; mm < 16; ++mm) {
        const int m = (tid >> 6) + 4 * mm;
        float sr = 0.f, si = 0.f;
        for (int c = 0; c < 64; ++c) { float w = Ws[kk * 65 + c]; int q = (m * c) & 63; sr += w * ct[q]; si -= w * st[q]; }
        u16* dst = Win + (size_t)l * NINP * DM + (size_t)(g * 64 + m) * DM + kt * 64 + kk;
        dst[0] = f2bf(sr); dst[(size_t)256 * DM] = f2bf(si);
      }
    }
  }
  {
    float* Ps = (float*)lds;
    float* Qs = Ps + 32 * 68;
    const int ty = tid >> 4, tx = tid & 15;
    for (int it = bid; it < NLAYER * 2 * 4 * 16; it += G) {
      const int l = it >> 7, wh = (it >> 6) & 1, kt = (it >> 4) & 3, nt = it & 15;
      const float* P = (wh ? p.w_pw2 : p.w_fourier) + (size_t)l * 256 * 256;
      const float* Qm = p.w_o + (size_t)l * DM * DM + (size_t)(wh ? 768 : 0) * DM;
      float acc[4][4];
#pragma unroll
      for (int a = 0; a < 4; ++a)
#pragma unroll
        for (int b = 0; b < 4; ++b) acc[a][b] = 0.f;
      for (int j0 = 0; j0 < 256; j0 += 32) {
        __syncthreads();
#pragma unroll
        for (int i = 0; i < 8; ++i) { int e = tid + 256 * i; int kk = e >> 5, jj = e & 31; Ps[jj * 68 + kk] = P[(size_t)(kt * 64 + kk) * 256 + j0 + jj]; }
#pragma unroll
        for (int i = 0; i < 8; ++i) { int e = tid + 256 * i; int jj = e >> 6, nn = e & 63; Qs[jj * 64 + nn] = Qm[(size_t)(j0 + jj) * DM + nt * 64 + nn]; }
        __syncthreads();
#pragma unroll 8
        for (int jj = 0; jj < 32; ++jj) {
          const float4 a4 = *(const float4*)&Ps[jj * 68 + ty * 4]; const float4 b4 = *(const float4*)&Qs[jj * 64 + tx * 4];
          const float av[4] = {a4.x, a4.y, a4.z, a4.w}, bv[4] = {b4.x, b4.y, b4.z, b4.w};
#pragma unroll
          for (int a = 0; a < 4; ++a)
#pragma unroll
            for (int b = 0; b < 4; ++b) acc[a][b] += av[a] * bv[b];
        }
      }
#pragma unroll
      for (int b = 0; b < 4; ++b) {
        const int n = nt * 64 + tx * 4 + b, k = (wh ? 768 : 0) + kt * 64 + ty * 4;
        *(u32x2*)(Wo + (size_t)l * DM * DM + (size_t)n * DM + k) = pack4(acc[0][b], acc[1][b], acc[2][b], acc[3][b]);
      }
    }
  }
}

DI void phase_norm(const Params& p, int l, int which) {
  const int tid_ = ltid(); const int lane = tid_ & 63, wave = tid_ >> 6;
  const float* g = (which ? p.norm2_g : p.norm1_g) + l * DM;
  u16* H = (u16*)(p.ws + OFF_H);
  for (int row = blockIdx.x * 4 + wave; row < NT; row += gridDim.x * 4) {
    const float* xr = xrow(p, row);
    const int mi = mod_index(row);
    const float* shift = modp(p, l, mi, which ? 3 : 0); const float* scale = modp(p, l, mi, which ? 4 : 1);
    float4 v[4]; float ss = 0.f;
#pragma unroll
    for (int i = 0; i < 4; ++i) { v[i] = *(const float4*)(xr + i * 256 + lane * 4); ss += v[i].x * v[i].x + v[i].y * v[i].y + v[i].z * v[i].z + v[i].w * v[i].w; }
    ss = wave_sum(ss);
    const float rinv = rsqrtf(ss * (1.f / DM) + EPS);
#pragma unroll
    for (int i = 0; i < 4; ++i) {
      const int c = i * 256 + lane * 4;
      const float4 g4 = *(const float4*)(g + c), sc = *(const float4*)(scale + c), sh = *(const float4*)(shift + c);
      *(u32x2*)(H + (size_t)row * DM + c) = pack4(v[i].x * rinv * g4.x * (1.f + sc.x) + sh.x, v[i].y * rinv * g4.y * (1.f + sc.y) + sh.y,
                                                 v[i].z * rinv * g4.z * (1.f + sc.z) + sh.z, v[i].w * rinv * g4.w * (1.f + sc.w) + sh.w);
    }
  }
}

DI void phase_win(const Params& p, int l, char* lds) {
  const int tid = ltid(), lane = tid & 63, wave = tid >> 6, r = lane & 31, h = lane >> 5, wa = wave >> 1, wb = wave & 1;
  const u16* Win = (const u16*)(p.ws + OFF_WIN) + (size_t)l * NINP * DM;
  const u16* H = (const u16*)(p.ws + OFF_H);
  u16* Z = (u16*)(p.ws + OFF_Z); u16* Kb = (u16*)(p.ws + OFF_K);
  const float2* RP = (const float2*)(p.ws + OFF_ROPE);
  for (int t = blockIdx.x; t < MT * 12; t += gridDim.x) {
    const int mt = t / 12, nt = t % 12;
    f32x16 acc[2][2]; float rinv[2];
    const u16* Hb = H + (size_t)mt * 128 * DM;
    gemm128<0, false>(Win + (size_t)nt * 128 * DM, DM, [&](int i) { return Hb + (size_t)i * DM; }, DM, lds, acc, rinv);
#pragma unroll
    for (int i = 0; i < 2; ++i) {
      const int nb = nt * 128 + wa * 64 + i * 32;
      if (nb >= ZW) continue;
#pragma unroll
      for (int j = 0; j < 2; ++j) {
        const int m = mt * 128 + wb * 64 + j * 32 + r;
        if (nb != 896) {
#pragma unroll
          for (int g = 0; g < 4; ++g)
            *(u32x2*)(Z + (size_t)m * ZW + nb + 8 * g + 4 * h) = pack4(acc[i][j][4 * g], acc[i][j][4 * g + 1], acc[i][j][4 * g + 2], acc[i][j][4 * g + 3]);
        } else {
          int b, key, pos; bool lat; tok_info(m, b, key, lat, pos);
          f32x16 v = acc[i][j];
          if (lat) rope_block(v, h, pos, RP);
#pragma unroll
          for (int g = 0; g < 4; ++g) {
            const u32x2 pk = pack4(v[4 * g], v[4 * g + 1], v[4 * g + 2], v[4 * g + 3]);
#pragma unroll
            for (int hh = 0; hh < NH; ++hh) *(u32x2*)(Kb + ((size_t)(b * NH + hh) * NKEYS + key) * 96 + 64 + 8 * g + 4 * h) = pk;
          }
        }
      }
    }
  }
}

DI void mid_upq(const Params& p, int l, int t, char* lds) {
  const int tid = ltid(), lane = tid & 63, wave = tid >> 6, r = lane & 31, h = lane >> 5, wa = wave >> 1, wb = wave & 1;
  const int mt = t / 6, nt = t % 6;
  const u16* W = (const u16*)(p.ws + OFF_WUQ) + (size_t)l * 768 * 256 + (size_t)nt * 128 * 256;
  const u16* Zb = (const u16*)(p.ws + OFF_Z) + (size_t)mt * 128 * ZW + 512;
  u16* Q = (u16*)(p.ws + OFF_Q);
  const float2* RP = (const float2*)(p.ws + OFF_ROPE);
  f32x16 acc[2][2]; float rinv[2];
  gemm128<0, true>(W, 256, [&](int i) { return Zb + (size_t)i * ZW; }, 256, lds, acc, rinv);
#pragma unroll
  for (int i = 0; i < 2; ++i) {
    const int nb = nt * 128 + wa * 64 + i * 32;
    const bool ropeblk = ((nb >> 5) % 3) == 2;
#pragma unroll
    for (int j = 0; j < 2; ++j) {
      const int m = mt * 128 + wb * 64 + j * 32 + r;
      const float sc = rinv[j] * QSCALE;
      f32x16 v;
#pragma unroll
      for (int q = 0; q < 16; ++q) v[q] = acc[i][j][q] * sc;
      if (ropeblk && m < NLAT) rope_block(v, h, m & (SEQ - 1), RP);
#pragma unroll
      for (int g = 0; g < 4; ++g) *(u32x2*)(Q + (size_t)m * 768 + nb + 8 * g + 4 * h) = pack4(v[4 * g], v[4 * g + 1], v[4 * g + 2], v[4 * g + 3]);
    }
  }
}
DI void mid_upkv(const Params& p, int l, int t, char* lds) {
  const int tid = ltid(), lane = tid & 63, wave = tid >> 6, r = lane & 31, h = lane >> 5, wa = wave >> 1, wb = wave & 1;
  const int mt = t / 8, hh = t % 8;
  const u16* W = (const u16*)(p.ws + OFF_WUKV) + (size_t)l * 1024 * 128 + (size_t)hh * 128 * 128;
  const u16* Zb = (const u16*)(p.ws + OFF_Z) + (size_t)mt * 128 * ZW + 768;
  u16* Kb = (u16*)(p.ws + OFF_K); u16* Vt = (u16*)(p.ws + OFF_VT);
  f32x16 acc[2][2]; float rinv[2];
  gemm128<0, true>(W, 128, [&](int i) { return Zb + (size_t)i * ZW; }, 128, lds, acc, rinv);
#pragma unroll
  for (int j = 0; j < 2; ++j) {
    const int m = mt * 128 + wb * 64 + j * 32 + r;
    int b, key, pos; bool lat; tok_info(m, b, key, lat, pos);
    const float sc = rinv[j];
#pragma unroll
    for (int i = 0; i < 2; ++i) {
      if (wa == 0) {
#pragma unroll
        for (int g = 0; g < 4; ++g)
          *(u32x2*)(Kb + ((size_t)(b * NH + hh) * NKEYS + key) * 96 + i * 32 + 8 * g + 4 * h) =
              pack4(acc[i][j][4 * g] * sc, acc[i][j][4 * g + 1] * sc, acc[i][j][4 * g + 2] * sc, acc[i][j][4 * g + 3] * sc);
      } else {
        const int kp = vpos(key);
#pragma unroll
        for (int q = 0; q < 16; ++q) {
          const int d = i * 32 + crow(q, h);
          Vt[((size_t)(b * NH + hh) * 64 + d) * NKEYS + kp] = f2bf(acc[i][j][q] * sc);
        }
      }
    }
  }
}
DI void mid_conv(const Params& p, int l, int it, char* lds) {
  const int tid = ltid(), lane = tid & 63, wave = tid >> 6;
  const int row0 = it * 32;
  int seqbase, n0, N;
  if (row0 < NLAT) { seqbase = row0 & ~(SEQ - 1); n0 = row0 & (SEQ - 1); N = SEQ; }
  else { int rr = row0 - NLAT; seqbase = NLAT + (rr & ~255); n0 = rr & 255; N = CTXL; }
  const u16* Z = (const u16*)(p.ws + OFF_Z);
  u16* CAT = (u16*)(p.ws + OFF_CAT);
  float* co = (float*)lds;
  const int c = tid;
  float w[31];
#pragma unroll
  for (int j = 0; j < 31; ++j) w[j] = p.w_dw[((size_t)l * 31 + j) * 256 + c];
  float acc[32];
  const float bias = p.b_dw[l * 256 + c];
#pragma unroll
  for (int t = 0; t < 32; ++t) acc[t] = bias;
#pragma unroll
  for (int rr = 0; rr < 62; ++rr) {
    const int n = n0 - 15 + rr;
    float u = 0.f;
    if (n >= 0 && n < N) {
      const u16* zr = Z + (size_t)(seqbase + n) * ZW;
      const float a = bf2f(zr[928 + c]), g = bf2f(zr[1184 + c]);
      u = a * sigmoidf_(g);
    }
#pragma unroll
    for (int t = 0; t < 32; ++t) {
      const int j = rr - t;
      if (j >= 0 && j < 31) acc[t] += w[j] * u;
    }
  }
  __syncthreads();
#pragma unroll
  for (int t = 0; t < 32; ++t) co[t * 256 + c] = acc[t];
  __syncthreads();
  const float4 lg = *(const float4*)(p.conv_ln_g + l * 256 + lane * 4), lb = *(const float4*)(p.conv_ln_b + l * 256 + lane * 4);
#pragma unroll
  for (int tt = 0; tt < 8; ++tt) {
    const int t = wave * 8 + tt;
    const float4 x = *(const float4*)(co + t * 256 + lane * 4);
    const float mu = wave_sum(x.x + x.y + x.z + x.w) * (1.f / 256.f);
    const float d0 = x.x - mu, d1 = x.y - mu, d2 = x.z - mu, d3 = x.w - mu;
    const float var = wave_sum(d0 * d0 + d1 * d1 + d2 * d2 + d3 * d3) * (1.f / 256.f);
    const float ri = rsqrtf(var + EPS);
    float y0 = d0 * ri * lg.x + lb.x, y1 = d1 * ri * lg.y + lb.y, y2 = d2 * ri * lg.z + lb.z, y3 = d3 * ri * lg.w + lb.w;
    y0 *= sigmoidf_(y0); y1 *= sigmoidf_(y1); y2 *= sigmoidf_(y2); y3 *= sigmoidf_(y3);
    *(u32x2*)(CAT + (size_t)(row0 + t) * DM + 768 + lane * 4) = pack4(y0, y1, y2, y3);
  }
}
DI void mid_fft1(const Params& p, int t, char* lds) {
  const int tid = ltid(), lane = tid & 63, wave = tid >> 6, r = lane & 31, h = lane >> 5, wa = wave >> 1, wb = wave & 1;
  const int ntile = t & 1, mt = (t >> 1) & 1, n2 = (t >> 2) & 127, b = t >> 9;
  const u16* A1 = (const u16*)(p.ws + OFF_A1T) + (size_t)mt * 128 * 256;
  const u16* Z = (const u16*)(p.ws + OFF_Z);
  u16* Y = (u16*)(p.ws + OFF_Y);
  const float2* TW = (const float2*)(p.ws + OFF_TW);
  f32x16 acc[2][2]; float rinv[2];
  gemm128<1, false>(A1, 256, [&](int k) { return Z + (size_t)(b * SEQ + 128 * (k & 127) + n2) * ZW + (k >> 7) * 256 + ntile * 128; }, 256, lds, acc, rinv);
#pragma unroll
  for (int j = 0; j < 2; ++j) {
    const int ch = ntile * 128 + wb * 64 + j * 32 + r;
#pragma unroll
    for (int q = 0; q < 16; ++q) {
      const int k1 = mt * 64 + wa * 32 + crow(q, h);
      const float2 tw = TW[n2 * k1];
      const float yr = acc[0][j][q], yi = acc[1][j][q];
      u16* dst = Y + ((size_t)(b * 128 + k1) * 128 + n2) * 512 + ch;
      dst[0] = f2bf(yr * tw.x + yi * tw.y);
      dst[256] = f2bf(yi * tw.x - yr * tw.y);
    }
  }
}
DI void mid_ctxdft(const Params& p, int t, char* lds) {
  const int tid = ltid(), lane = tid & 63, wave = tid >> 6, r = lane & 31, h = lane >> 5, wa = wave >> 1, wb = wave & 1;
  const int ntile = t & 1, mt = (t >> 1) & 1, b = t >> 2;
  const u16* A3 = (const u16*)(p.ws + OFF_A3T) + (size_t)mt * 128 * 512;
  const u16* Z = (const u16*)(p.ws + OFF_Z);
  u16* CAT = (u16*)(p.ws + OFF_CAT);
  f32x16 acc[2][2]; float rinv[2];
  gemm128<1, false>(A3, 512, [&](int k) { return Z + (size_t)(NLAT + b * 256 + (k & 255)) * ZW + (k >> 8) * 256 + ntile * 128; }, 512, lds, acc, rinv);
#pragma unroll
  for (int i = 0; i < 2; ++i)
#pragma unroll
    for (int j = 0; j < 2; ++j) {
      const int ch = ntile * 128 + wb * 64 + j * 32 + r;
#pragma unroll
      for (int q = 0; q < 16; ++q) {
        const int kk = mt * 128 + wa * 64 + i * 32 + crow(q, h);
        CAT[(size_t)(NLAT + b * 256 + kk) * DM + ch] = f2bf(acc[i][j][q] * (1.f / 128.f));
      }
    }
}
constexpr int N_UPQ = MT * 6, N_UPKV = MT * 8, N_CONV = NT / 32, N_FFT1 = 2 * 128 * 4, N_CDFT = 8;
DI void phase_mid(const Params& p, int l, char* lds) {
  for (int it = blockIdx.x; it < N_UPQ + N_UPKV + N_CONV + N_FFT1 + N_CDFT; it += gridDim.x) {
    int t = it;
    if (t < N_UPQ) { mid_upq(p, l, t, lds); continue; }
    t -= N_UPQ;
    if (t < N_UPKV) { mid_upkv(p, l, t, lds); continue; }
    t -= N_UPKV;
    if (t < N_CONV) { mid_conv(p, l, t, lds); continue; }
    t -= N_CONV;
    if (t < N_FFT1) { mid_fft1(p, t, lds); continue; }
    t -= N_FFT1;
    mid_ctxdft(p, t, lds);
  }
}

constexpr int KP = 104, VP = 72;
DI void attn_item(const u16* __restrict__ Qp, const u16* __restrict__ Kp, const u16* __restrict__ Vp, int nkeys, u16* __restrict__ Op, char* lds) {
  const int tid = ltid(), lane = tid & 63, wave = tid >> 6, r = lane & 31, h = lane >> 5;
  u16* Ks = (u16*)lds;
  u16* Vs = Ks + 2 * 64 * KP;
  bf16x8 qf[6];
  {
    const u16* qrow = Qp + (size_t)(wave * 32 + r) * 768 + 8 * h;
#pragma unroll
    for (int s = 0; s < 6; ++s) qf[s] = *(const bf16x8*)(qrow + 16 * s);
  }
  f32x16 o0, o1;
#pragma unroll
  for (int q = 0; q < 16; ++q) { o0[q] = 0.f; o1[q] = 0.f; }
  float m_run = -1e30f, l_run = 0.f;
  const int NTL = nkeys / 64;
  uint4 rk[3], rv[2];
  auto gload = [&](int t) {
    const int key0 = t * 64;
#pragma unroll
    for (int i = 0; i < 3; ++i) { int c = tid + 256 * i; rk[i] = *(const uint4*)(Kp + (size_t)key0 * 96 + c * 8); }
#pragma unroll
    for (int i = 0; i < 2; ++i) { int c = tid + 256 * i; int d = c >> 3, ch = c & 7; rv[i] = *(const uint4*)(Vp + (size_t)d * NKEYS + key0 + ch * 8); }
  };
  auto sstore = [&](int buf) {
#pragma unroll
    for (int i = 0; i < 3; ++i) { int c = tid + 256 * i; int row = c / 12, kc = c % 12; *(uint4*)(Ks + buf * 64 * KP + row * KP + kc * 8) = rk[i]; }
#pragma unroll
    for (int i = 0; i < 2; ++i) { int c = tid + 256 * i; int d = c >> 3, ch = c & 7; *(uint4*)(Vs + buf * 64 * VP + d * VP + ch * 8) = rv[i]; }
  };
  __syncthreads();
  gload(0); sstore(0); __syncthreads();
  for (int t = 0; t < NTL; ++t) {
    const int cur = t & 1;
    if (t + 1 < NTL) gload(t + 1);
    const u16* Kb = Ks + cur * 64 * KP + r * KP + 8 * h;
    const u16* Vb = Vs + cur * 64 * VP + r * VP + 8 * h;
    f32x16 s0, s1;
#pragma unroll
    for (int q = 0; q < 16; ++q) { s0[q] = 0.f; s1[q] = 0.f; }
#pragma unroll
    for (int s = 0; s < 6; ++s) {
      const bf16x8 a0 = *(const bf16x8*)(Kb + 16 * s), a1 = *(const bf16x8*)(Kb + 32 * KP + 16 * s);
      s0 = MFMA(a0, qf[s], s0); s1 = MFMA(a1, qf[s], s1);
    }
    float mt_ = s0[0];
#pragma unroll
    for (int q = 1; q < 16; ++q) mt_ = fmaxf(mt_, s0[q]);
#pragma unroll
    for (int q = 0; q < 16; ++q) mt_ = fmaxf(mt_, s1[q]);
    mt_ = swap_max(mt_);
    const float mn = fmaxf(m_run, mt_);
    const float alpha = __builtin_amdgcn_exp2f(m_run - mn);
    m_run = mn;
    float ps = 0.f;
#pragma unroll
    for (int q = 0; q < 16; ++q) { s0[q] = __builtin_amdgcn_exp2f(s0[q] - mn); ps += s0[q]; }
#pragma unroll
    for (int q = 0; q < 16; ++q) { s1[q] = __builtin_amdgcn_exp2f(s1[q] - mn); ps += s1[q]; }
    l_run = l_run * alpha + ps;
#pragma unroll
    for (int q = 0; q < 16; ++q) { o0[q] *= alpha; o1[q] *= alpha; }
    bf16x8 pf[4];
    {
      u32x4 w;
      w[0] = cvtpk(s0[0], s0[1]); w[1] = cvtpk(s0[2], s0[3]); w[2] = cvtpk(s0[4], s0[5]); w[3] = cvtpk(s0[6], s0[7]); pf[0] = __builtin_bit_cast(bf16x8, w);
      w[0] = cvtpk(s0[8], s0[9]); w[1] = cvtpk(s0[10], s0[11]); w[2] = cvtpk(s0[12], s0[13]); w[3] = cvtpk(s0[14], s0[15]); pf[1] = __builtin_bit_cast(bf16x8, w);
      w[0] = cvtpk(s1[0], s1[1]); w[1] = cvtpk(s1[2], s1[3]); w[2] = cvtpk(s1[4], s1[5]); w[3] = cvtpk(s1[6], s1[7]); pf[2] = __builtin_bit_cast(bf16x8, w);
      w[0] = cvtpk(s1[8], s1[9]); w[1] = cvtpk(s1[10], s1[11]); w[2] = cvtpk(s1[12], s1[13]); w[3] = cvtpk(s1[14], s1[15]); pf[3] = __builtin_bit_cast(bf16x8, w);
    }
#pragma unroll
    for (int sl = 0; sl < 4; ++sl) {
      const bf16x8 v0 = *(const bf16x8*)(Vb + 16 * sl), v1 = *(const bf16x8*)(Vb + 32 * VP + 16 * sl);
      o0 = MFMA(v0, pf[sl], o0); o1 = MFMA(v1, pf[sl], o1);
    }
    if (t + 1 < NTL) sstore(cur ^ 1);
    __syncthreads();
  }
  const float linv = 1.f / swap_sum(l_run);
  u16* orow = Op + (size_t)(wave * 32 + r) * DM;
#pragma unroll
  for (int g = 0; g < 4; ++g) {
    *(u32x2*)(orow + 8 * g + 4 * h) = pack4(o0[4 * g] * linv, o0[4 * g + 1] * linv, o0[4 * g + 2] * linv, o0[4 * g + 3] * linv);
    *(u32x2*)(orow + 32 + 8 * g + 4 * h) = pack4(o1[4 * g] * linv, o1[4 * g + 1] * linv, o1[4 * g + 2] * linv, o1[4 * g + 3] * linv);
  }
}
DI void attn_fft2(const Params& p, int t, char* lds) {
  const int tid = ltid(), lane = tid & 63, wave = tid >> 6, r = lane & 31, h = lane >> 5, wa = wave >> 1, wb = wave & 1;
  const int ntile = t & 1, k1 = (t >> 1) & 127, b = t >> 8;
  const u16* A2 = (const u16*)(p.ws + OFF_A2T);
  const u16* Y = (const u16*)(p.ws + OFF_Y);
  u16* CAT = (u16*)(p.ws + OFF_CAT);
  f32x16 acc[2][2]; float rinv[2];
  gemm128<1, false>(A2, 256, [&](int k) { return Y + ((size_t)(b * 128 + k1) * 128 + (k & 127)) * 512 + (k >> 7) * 256 + ntile * 128; }, 256, lds, acc, rinv);
#pragma unroll
  for (int i = 0; i < 2; ++i)
#pragma unroll
    for (int j = 0; j < 2; ++j) {
      const int ch = ntile * 128 + wb * 64 + j * 32 + r;
#pragma unroll
      for (int q = 0; q < 16; ++q) {
        const int k2 = wa * 64 + i * 32 + crow(q, h);
        CAT[(size_t)(b * SEQ + k1 + 128 * k2) * DM + ch] = f2bf(acc[i][j][q] * (1.f / 1024.f));
      }
    }
}
constexpr int N_FFT2 = 2 * 128 * 2, N_ACTX = 2 * NH * 2, N_ALAT = 2 * NH * 128;
DI void phase_attn(const Params& p, char* lds) {
  const u16* Q = (const u16*)(p.ws + OFF_Q); const u16* Kb = (const u16*)(p.ws + OFF_K); const u16* Vt = (const u16*)(p.ws + OFF_VT);
  u16* CAT = (u16*)(p.ws + OFF_CAT);
  for (int it = blockIdx.x; it < N_FFT2 + N_ACTX + N_ALAT; it += gridDim.x) {
    int t = it;
    if (t < N_FFT2) { attn_fft2(p, t, lds); continue; }
    t -= N_FFT2;
    if (t < N_ACTX) {
      const int qt = t & 1, hh = (t >> 1) & 7, b = t >> 4;
      const int row0 = NLAT + b * 256 + qt * 128;
      attn_item(Q + (size_t)row0 * 768 + hh * 96, Kb + (size_t)(b * NH + hh) * NKEYS * 96, Vt + (size_t)(b * NH + hh) * 64 * NKEYS, CTXL,
                CAT + (size_t)row0 * DM + 256 + hh * 64, lds);
      continue;
    }
    t -= N_ACTX;
    {
      const int qt = t & 127, hh = (t >> 7) & 7, b = t >> 10;
      const int row0 = b * SEQ + qt * 128;
      attn_item(Q + (size_t)row0 * 768 + hh * 96, Kb + (size_t)(b * NH + hh) * NKEYS * 96, Vt + (size_t)(b * NH + hh) * 64 * NKEYS, NKEYS,
                CAT + (size_t)row0 * DM + 256 + hh * 64, lds);
    }
  }
}

DI void phase_wo(const Params& p, int l, char* lds) {
  const int tid = ltid(), lane = tid & 63, wave = tid >> 6, r = lane & 31, h = lane >> 5, wa = wave >> 1, wb = wave & 1;
  const u16* Wo = (const u16*)(p.ws + OFF_WO) + (size_t)l * DM * DM;
  const u16* CAT = (const u16*)(p.ws + OFF_CAT);
  for (int t = blockIdx.x; t < MT * 8; t += gridDim.x) {
    const int mt = t / 8, nt = t % 8;
    f32x16 acc[2][2]; float rinv[2];
    const u16* Cb = CAT + (size_t)mt * 128 * DM;
    gemm128<0, false>(Wo + (size_t)nt * 128 * DM, DM, [&](int i) { return Cb + (size_t)i * DM; }, DM, lds, acc, rinv);
    const float* gate = modp(p, l, mod_index(mt * 128), 2);
#pragma unroll
    for (int i = 0; i < 2; ++i)
#pragma unroll
      for (int j = 0; j < 2; ++j) {
        const int m = mt * 128 + wb * 64 + j * 32 + r;
        float* xr = xrow(p, m);
#pragma unroll
        for (int g = 0; g < 4; ++g) {
          const int n = nt * 128 + wa * 64 + i * 32 + 8 * g + 4 * h;
          const float4 gt = *(const float4*)(gate + n);
          float4 xv = *(float4*)(xr + n);
          xv.x += gt.x * acc[i][j][4 * g]; xv.y += gt.y * acc[i][j][4 * g + 1]; xv.z += gt.z * acc[i][j][4 * g + 2]; xv.w += gt.w * acc[i][j][4 * g + 3];
          *(float4*)(xr + n) = xv;
        }
      }
  }
}
DI void phase_mlp1(const Params& p, int l, char* lds) {
  const int tid = ltid(), lane = tid & 63, wave = tid >> 6, r = lane & 31, h = lane >> 5, wa = wave >> 1, wb = wave & 1;
  const u16* W1 = (const u16*)(p.ws + OFF_W1) + (size_t)l * DFF * DM;
  const u16* H = (const u16*)(p.ws + OFF_H);
  u16* A1 = (u16*)(p.ws + OFF_A1);
  for (int t = blockIdx.x; t < MT * 32; t += gridDim.x) {
    const int mt = t / 32, nt = t % 32;
    f32x16 acc[2][2]; float rinv[2];
    const u16* Hb = H + (size_t)mt * 128 * DM;
    gemm128<0, false>(W1 + (size_t)nt * 128 * DM, DM, [&](int i) { return Hb + (size_t)i * DM; }, DM, lds, acc, rinv);
#pragma unroll
    for (int i = 0; i < 2; ++i)
#pragma unroll
      for (int j = 0; j < 2; ++j) {
        const int m = mt * 128 + wb * 64 + j * 32 + r;
#pragma unroll
        for (int g = 0; g < 4; ++g) {
          const int n = nt * 128 + wa * 64 + i * 32 + 8 * g + 4 * h;
          float a = fmaxf(acc[i][j][4 * g], 0.f), b = fmaxf(acc[i][j][4 * g + 1], 0.f), c = fmaxf(acc[i][j][4 * g + 2], 0.f), d = fmaxf(acc[i][j][4 * g + 3], 0.f);
          *(u32x2*)(A1 + (size_t)m * DFF + n) = pack4(a * a, b * b, c * c, d * d);
        }
      }
  }
}
DI void phase_mlp2(const Params& p, int l, char* lds) {
  const int tid = ltid(), lane = tid & 63, wave = tid >> 6, r = lane & 31, h = lane >> 5, wa = wave >> 1, wb = wave & 1;
  const u16* W2 = (const u16*)(p.ws + OFF_W2) + (size_t)l * DM * DFF;
  const u16* A1 = (const u16*)(p.ws + OFF_A1);
  for (int t = blockIdx.x; t < MT * 8; t += gridDim.x) {
    const int mt = t / 8, nt = t % 8;
    f32x16 acc[2][2]; float rinv[2];
    const u16* Ab = A1 + (size_t)mt * 128 * DFF;
    gemm128<0, false>(W2 + (size_t)nt * 128 * DFF, DFF, [&](int i) { return Ab + (size_t)i * DFF; }, DFF, lds, acc, rinv);
    const float* gate = modp(p, l, mod_index(mt * 128), 5);
#pragma unroll
    for (int i = 0; i < 2; ++i)
#pragma unroll
      for (int j = 0; j < 2; ++j) {
        const int m = mt * 128 + wb * 64 + j * 32 + r;
        float* xr = xrow(p, m);
#pragma unroll
        for (int g = 0; g < 4; ++g) {
          const int n = nt * 128 + wa * 64 + i * 32 + 8 * g + 4 * h;
          const float4 gt = *(const float4*)(gate + n);
          float4 xv = *(float4*)(xr + n);
          xv.x += gt.x * acc[i][j][4 * g]; xv.y += gt.y * acc[i][j][4 * g + 1]; xv.z += gt.z * acc[i][j][4 * g + 2]; xv.w += gt.w * acc[i][j][4 * g + 3];
          *(float4*)(xr + n) = xv;
        }
      }
  }
}
DI void phase_final(const Params& p) {
  const int tid_ = ltid(); const int lane = tid_ & 63, wave = tid_ >> 6;
  for (int row = blockIdx.x * 4 + wave; row < NLAT; row += gridDim.x * 4) {
    float* xr = p.out + (size_t)row * DM;
    float4 v[4]; float ss = 0.f;
#pragma unroll
    for (int i = 0; i < 4; ++i) { v[i] = *(const float4*)(xr + i * 256 + lane * 4); ss += v[i].x * v[i].x + v[i].y * v[i].y + v[i].z * v[i].z + v[i].w * v[i].w; }
    ss = wave_sum(ss);
    const float rinv = rsqrtf(ss * (1.f / DM) + EPS);
#pragma unroll
    for (int i = 0; i < 4; ++i) {
      const int c = i * 256 + lane * 4;
      const float4 g4 = *(const float4*)(p.final_norm_g + c);
      *(float4*)(xr + c) = make_float4(v[i].x * rinv * g4.x, v[i].y * rinv * g4.y, v[i].z * rinv * g4.z, v[i].w * rinv * g4.w);
    }
  }
}

constexpr int N_PHASES = 2 + 8 * NLAYER;
DI void run_phase(const Params& p, int ph, char* lds) {
  if (ph == 0) { phase_prep(p, lds); return; }
  if (ph == N_PHASES - 1) { phase_final(p); return; }
  const int l = (ph - 1) >> 3, s = (ph - 1) & 7;
  switch (s) {
    case 0: phase_norm(p, l, 0); break;
    case 1: phase_win(p, l, lds); break;
    case 2: phase_mid(p, l, lds); break;
    case 3: phase_attn(p, lds); break;
    case 4: phase_wo(p, l, lds); break;
    case 5: phase_norm(p, l, 1); break;
    case 6: phase_mlp1(p, l, lds); break;
    default: phase_mlp2(p, l, lds); break;
  }
}

extern __shared__ __attribute__((aligned(16))) char dyn_lds[];

__global__ void __launch_bounds__(256, 2) mega_kernel(Params p) {
  cg::grid_group grid = cg::this_grid();
  for (int ph = 0; ph < N_PHASES; ++ph) {
    run_phase(p, ph, dyn_lds);
    if (ph + 1 < N_PHASES) grid.sync();
  }
}
#if MK_MULTI
__global__ void __launch_bounds__(256, 2) phase_kernel(Params p, int ph) { run_phase(p, ph, dyn_lds); }
#endif

extern "C" void kernel_launch(void* const* d_in, const int* in_sizes, int n_in, void* d_out, int out_size, void* d_ws, size_t ws_size,
                              hipStream_t stream) {
  Params p{};
  const float** f = (const float**)&p;
  for (int i = 0; i < 23; ++i) f[i] = (const float*)d_in[i];
  p.out = (float*)d_out;
  p.ws = (char*)d_ws;
  if (ws_size < WS_NEED) { fprintf(stderr, "kernel_launch: ws too small: %zu < %zu\n", ws_size, (size_t)WS_NEED); return; }
  static int grid_blocks = 0;
  if (!grid_blocks) {
    (void)hipFuncSetAttribute((const void*)mega_kernel, hipFuncAttributeMaxDynamicSharedMemorySize, LDS_BYTES);
#if MK_MULTI
    (void)hipFuncSetAttribute((const void*)phase_kernel, hipFuncAttributeMaxDynamicSharedMemorySize, LDS_BYTES);
#endif
    int dev = 0, cus = 0, per_cu = 0;
    (void)hipGetDevice(&dev);
    (void)hipDeviceGetAttribute(&cus, hipDeviceAttributeMultiprocessorCount, dev);
    (void)hipOccupancyMaxActiveBlocksPerMultiprocessor(&per_cu, mega_kernel, 256, LDS_BYTES);
    if (per_cu > 2) per_cu = 2;
    if (per_cu < 1) per_cu = 1;
    grid_blocks = cus * per_cu;
  }
#if MK_MULTI
  for (int ph = 0; ph < N_PHASES; ++ph) hipLaunchKernelGGL(phase_kernel, dim3(grid_blocks), dim3(256), LDS_BYTES, stream, p, ph);
#else
  void* args[] = {&p};
  hipError_t e = hipLaunchCooperativeKernel((void*)mega_kernel, dim3(grid_blocks), dim3(256), args, LDS_BYTES, stream);
  if (e != hipSuccess) fprintf(stderr, "cooperative launch failed: %s (grid %d)\n", hipGetErrorString(e), grid_blocks);
#endif
}
```

```cpp
#include <hip/hip_runtime.h>
#include <hip/hip_cooperative_groups.h>
#include <cstdio>
#include <cstdint>
namespace cg = cooperative_groups;

#ifndef MK_MULTI
#define MK_MULTI 0
#endif

typedef unsigned short u16;
using bf16x8 = __attribute__((ext_vector_type(8))) short;
using f32x16 = __attribute__((ext_vector_type(16))) float;
using u32x4  = __attribute__((ext_vector_type(4))) unsigned;
using u32x2  = __attribute__((ext_vector_type(2))) unsigned;
#define DI __device__ __forceinline__
#define MFMA(a, b, c) __builtin_amdgcn_mfma_f32_32x32x16_bf16((a), (b), (c), 0, 0, 0)

constexpr int DM = 1024, NLAT = 32768, NCTX = 512, NT = NLAT + NCTX, SEQ = 16384, CTXL = 256, NLAYER = 4;
constexpr int ZW = 1440, NINP = 1536, DFF = 4096, NKEYS = SEQ + CTXL, NH = 8;
constexpr int MT = NT / 128;
constexpr float EPS = 1e-6f;
constexpr float QSCALE = 0.10206207261596575f * 1.4426950408889634f;

constexpr size_t al256(size_t x) { return (x + 255) / 256 * 256; }
constexpr size_t SZ_WIN = (size_t)NLAYER * NINP * DM * 2, SZ_WUQ = (size_t)NLAYER * 768 * 256 * 2, SZ_WUKV = (size_t)NLAYER * 1024 * 256 * 2;
constexpr size_t SZ_WO = (size_t)NLAYER * DM * DM * 2, SZ_W1 = (size_t)NLAYER * DFF * DM * 2, SZ_W2 = SZ_W1;
constexpr size_t OFF_WIN = 0, OFF_WUQ = OFF_WIN + SZ_WIN, OFF_WUKV = OFF_WUQ + SZ_WUQ, OFF_WO = OFF_WUKV + SZ_WUKV;
constexpr size_t OFF_W1 = OFF_WO + SZ_WO, OFF_W2 = OFF_W1 + SZ_W1, OFF_MOD = OFF_W2 + SZ_W2;
constexpr size_t OFF_A1T = OFF_MOD + al256((size_t)NLAYER * 3 * 6144 * 4);
constexpr size_t OFF_A2T = OFF_A1T + 256 * 256 * 2, OFF_A3T = OFF_A2T + 128 * 256 * 2, OFF_TW = OFF_A3T + 256 * 512 * 2;
constexpr size_t OFF_ROPE = OFF_TW + 16384 * 8, OFF_XRC = OFF_ROPE + 256 * 8 * 8, OFF_H = OFF_XRC + (size_t)NCTX * DM * 4;
constexpr size_t OFF_UNI = OFF_H + (size_t)NT * DM * 2;
constexpr size_t OFF_Z = OFF_UNI, OFF_Q = OFF_Z + (size_t)NT * ZW * 2, OFF_K = OFF_Q + (size_t)NT * 768 * 2;
constexpr size_t OFF_VT = OFF_K + (size_t)2 * NH * NKEYS * 96 * 2, OFF_CAT = OFF_VT + (size_t)2 * NH * 64 * NKEYS * 2;
constexpr size_t OFF_Y = OFF_CAT + (size_t)NT * DM * 2, UNI_END = OFF_Y + (size_t)2 * SEQ * 512 * 2;
constexpr size_t OFF_A1 = OFF_UNI, A1_END = OFF_A1 + (size_t)NT * DFF * 2;
constexpr size_t WS_NEED = UNI_END > A1_END ? UNI_END : A1_END;
constexpr int LDS_PHASE = 2 * 73728;
constexpr int LDS_BYTES = LDS_PHASE + 16;
constexpr size_t OFF_TS = al256(WS_NEED), OFF_BAR = OFF_TS + 4096, OFF_SLAB = al256(OFF_BAR + 3456 * 4), OFF_SSQ = OFF_SLAB + (size_t)8 * NCTX * DM * 4, WS_TOTAL = OFF_SSQ + (size_t)NT * 2 * 4;

struct Params {
  const float *x, *c, *ctx, *c_ctx, *w_mod, *b_mod, *norm1_g, *w_in, *q_norm_g, *w_uq, *kv_norm_g, *w_ukv, *w_fourier, *w_dw, *b_dw,
      *conv_ln_g, *conv_ln_b, *w_pw2, *w_o, *norm2_g, *w_mlp1, *w_mlp2, *final_norm_g;
  float* out;
  char* ws;
};

DI int ltid() { int t = threadIdx.x; asm volatile("" : "+v"(t)); return t; }
DI int vbid() { int h = __builtin_amdgcn_readfirstlane((int)(threadIdx.x >> 8)); asm volatile("" : "+s"(h)); return blockIdx.x * 2 + h; }
DI int vgrid() { return gridDim.x * 2; }
#define LAS __attribute__((address_space(3)))
using f32x4 = __attribute__((ext_vector_type(4))) float;
DI int crow(int reg, int h) { return (reg & 3) + 8 * (reg >> 2) + 4 * h; }
DI unsigned cvtpk(float lo, float hi) { unsigned r; asm("v_cvt_pk_bf16_f32 %0, %1, %2" : "=v"(r) : "v"(lo), "v"(hi)); return r; }
DI u16 f2bf(float x) { return (u16)(cvtpk(x, 0.f) & 0xffffu); }
DI float bf2f(u16 v) { return __uint_as_float(((unsigned)v) << 16); }
DI u32x2 pack4(float a, float b, float c, float d) { u32x2 r; r[0] = cvtpk(a, b); r[1] = cvtpk(c, d); return r; }
DI float shx(float v, int o) { const int ln = ltid() & 63; return __builtin_bit_cast(float, __builtin_amdgcn_ds_bpermute((ln ^ o) << 2, __builtin_bit_cast(int, v))); }
DI float wave_sum(float v) {
#pragma unroll
  for (int o = 32; o; o >>= 1) v += shx(v, o);
  return v;
}
DI float swap_max(float v) {
  auto rr = __builtin_amdgcn_permlane32_swap(__float_as_uint(v), __float_as_uint(v), false, false);
  return fmaxf(__uint_as_float(rr[0]), __uint_as_float(rr[1]));
}
DI float swap_sum(float v) {
  auto rr = __builtin_amdgcn_permlane32_swap(__float_as_uint(v), __float_as_uint(v), false, false);
  return __uint_as_float(rr[0]) + __uint_as_float(rr[1]);
}
DI float sigmoidf_(float x) { return 1.f / (1.f + __expf(-x)); }
DI float* xrow(const Params& p, int row) { return row < NLAT ? p.out + (size_t)row * DM : (float*)(p.ws + OFF_XRC) + (size_t)(row - NLAT) * DM; }
DI int mod_index(int row) { return row < NLAT ? (row >> 14) : 2; }
DI const float* modp(const Params& p, int l, int mi, int chunk) { return (const float*)(p.ws + OFF_MOD) + ((size_t)(l * 3 + mi) * 6 + chunk) * 1024; }
DI void tok_info(int m, int& b, int& key, bool& lat, int& pos) {
  if (m < NLAT) { b = m >> 14; pos = m & (SEQ - 1); key = CTXL + pos; lat = true; }
  else { int mm = m - NLAT; b = mm >> 8; pos = mm & 255; key = pos; lat = false; }
}
DI int vpos(int key) { return (key & ~12) | ((key & 4) << 1) | ((key & 8) >> 1); }


#define XB_TMO      128
#define XB_XCNT(j)  (256  + 64 * (j))
#define XB_XSUB(j)  (1280 + 64 * (j))
#define XB_XGEN(j)  (2304 + 64 * (j))
#define XB_TOP      3328
#define XB_TOPGEN   3392
#define XCD_BAR_WORDS 3456
#define XB_SPIN_CAP (1u << 22)
DI unsigned xb_ld(unsigned* p) { return __hip_atomic_load(p, __ATOMIC_RELAXED, __HIP_MEMORY_SCOPE_AGENT); }
DI unsigned xb_add(unsigned* p, unsigned v) { return __hip_atomic_fetch_add(p, v, __ATOMIC_RELAXED, __HIP_MEMORY_SCOPE_AGENT); }
DI unsigned xb_xcc_id() { return (unsigned)__builtin_amdgcn_s_getreg((3 << 11) | 20) & 0xFu; }
#define XB_SPIN(cond, bar) do { unsigned _sp = 0; while (cond) { __builtin_amdgcn_s_sleep(1); \
    if ((++_sp & 255u) == 0u) { if (xb_ld(&(bar)[XB_TMO])) break; if (_sp > XB_SPIN_CAP) { atomicAdd(&(bar)[XB_TMO], 1u); break; } } } } while (0)
struct XcdBarrier { unsigned* bar; unsigned x; volatile LAS unsigned* st; };
DI XcdBarrier xcd_barrier_post(unsigned* bar, volatile LAS unsigned* st) {
  XcdBarrier b; b.bar = bar; b.x = xb_xcc_id(); b.st = st;
  if (threadIdx.x == 0) (void)xb_add(&bar[XB_XCNT(b.x)], 1u);
  return b;
}
DI void xcd_barrier_complete(unsigned* bar, unsigned x, unsigned& nloc, unsigned& nx) {
  const unsigned G = gridDim.x * gridDim.y * gridDim.z;
  unsigned sum, cnt, mine, sp = 0u;
  for (;;) {
    sum = 0u; cnt = 0u; mine = 0u;
#pragma unroll
    for (unsigned j = 0; j < 16; ++j) { const unsigned c = xb_ld(&bar[XB_XCNT(j)]); sum += c; cnt += (c > 0u) ? 1u : 0u; mine = (j == x) ? c : mine; }
    if (sum == G) break;
    __builtin_amdgcn_s_sleep(1);
    if ((++sp & 255u) == 0u) { if (xb_ld(&bar[XB_TMO])) break; if (sp > XB_SPIN_CAP) { atomicAdd(&bar[XB_TMO], 1u); break; } }
  }
  nloc = mine > 0u ? mine : 1u; nx = cnt > 0u ? cnt : 1u;
}
DI void xcd_barrier(const XcdBarrier& b) {
  asm volatile("s_waitcnt vmcnt(0)" ::: "memory");
  __syncthreads();
  if (threadIdx.x == 0) {
    unsigned* bar = b.bar;
    __builtin_amdgcn_s_waitcnt(0);
    unsigned nloc = b.st[0], nx = b.st[1];
    if (nloc == 0u) { xcd_barrier_complete(bar, b.x, nloc, nx); b.st[0] = nloc; b.st[1] = nx; }
    const unsigned old = xb_add(&bar[XB_XSUB(b.x)], 1u);
    const unsigned gen = old / nloc;
    if (old + 1u == (gen + 1u) * nloc) {
      __builtin_amdgcn_fence(__ATOMIC_RELEASE, "agent");
      asm volatile("s_waitcnt vmcnt(0)" ::: "memory");
      const unsigned og = xb_add(&bar[XB_TOP], 1u);
      const unsigned tg = og / nx;
      if (og + 1u == (tg + 1u) * nx) xb_add(&bar[XB_TOPGEN], 1u);
      else XB_SPIN(xb_ld(&bar[XB_TOPGEN]) == tg, bar);
      __builtin_amdgcn_fence(__ATOMIC_ACQUIRE, "agent");
      xb_add(&bar[XB_XGEN(b.x)], 1u);
      asm volatile("s_waitcnt vmcnt(0)" ::: "memory");
    } else {
      XB_SPIN(xb_ld(&bar[XB_XGEN(b.x)]) == gen, bar);
      __builtin_amdgcn_fence(__ATOMIC_ACQUIRE, "agent");
      asm volatile("s_waitcnt vmcnt(0)" ::: "memory");
    }
  }
  __syncthreads();
}

template <int BT, bool RMS, class BRow>
DI void gemm128(const u16* __restrict__ A, int lda, BRow brow, int K, char* lds_, f32x16 (&acc)[2][2], float (&rinv)[2]) {
  static_assert(BT == 1 && !RMS, "only the transposed-B form is used");
  const int tid = ltid() & 255, lane = tid & 63, wave = __builtin_amdgcn_readfirstlane(tid >> 6), r = lane & 31, h = lane >> 5;
  const int wa = wave >> 1, wb = wave & 1;
  LAS char* lds = (LAS char*)lds_;
#pragma unroll
  for (int i = 0; i < 2; ++i)
#pragma unroll
    for (int j = 0; j < 2; ++j)
#pragma unroll
      for (int q = 0; q < 16; ++q) acc[i][j][q] = 0.f;
  rinv[0] = rinv[1] = 1.f;
  const int KT = K / 64;
  unsigned aoff[4];
#pragma unroll
  for (int i = 0; i < 4; ++i) { const int row = (wave * 4 + i) * 8 + (lane >> 3), sl = lane & 7; aoff[i] = (unsigned)(row * lda + ((sl ^ ((row >> 1) & 7)) << 3)) * 2u; }
  auto issue = [&](int kt, int buf) {
#pragma unroll
    for (int i = 0; i < 4; ++i)
      __builtin_amdgcn_global_load_lds((const unsigned*)((const char*)A + aoff[i] + kt * 128), (LAS unsigned*)(lds + buf * 32768 + (wave * 4 + i) * 1024), 16, 0, 0);
#pragma unroll
    for (int i = 0; i < 4; ++i) {
      const int kr = (wave * 4 + i) * 4 + (lane >> 4);
      __builtin_amdgcn_global_load_lds((const unsigned*)(brow(kt * 64 + kr) + (lane & 15) * 8), (LAS unsigned*)(lds + buf * 32768 + 16384 + (wave * 4 + i) * 1024), 16, 0, 0);
    }
  };
  const int y3 = (r >> 1) & 7;
  asm volatile("s_waitcnt vmcnt(0) lgkmcnt(0)" ::: "memory");
  __builtin_amdgcn_s_barrier();
  issue(0, 0);
  for (int kt = 0; kt < KT; ++kt) {
    const int cur = kt & 1;
    asm volatile("s_waitcnt vmcnt(0)" ::: "memory");
    __builtin_amdgcn_s_barrier();
    __builtin_amdgcn_sched_barrier(0);
    if (kt + 1 < KT) issue(kt + 1, cur ^ 1);
    __builtin_amdgcn_sched_barrier(0);
    LAS const char* Ab = lds + cur * 32768 + (wa * 64 + r) * 128;
    LAS const u16* Bb = (LAS const u16*)(lds + cur * 32768 + 16384);
#pragma unroll
    for (int ks = 0; ks < 4; ++ks) {
      bf16x8 af[2], bfr[2];
#pragma unroll
      for (int i = 0; i < 2; ++i) af[i] = *(const LAS bf16x8*)(Ab + i * 32 * 128 + (((2 * ks + h) ^ y3) << 4));
#pragma unroll
      for (int j = 0; j < 2; ++j)
#pragma unroll
        for (int q = 0; q < 8; ++q) bfr[j][q] = (short)Bb[(ks * 16 + 8 * h + q) * 128 + wb * 64 + j * 32 + r];
#pragma unroll
      for (int i = 0; i < 2; ++i)
#pragma unroll
        for (int j = 0; j < 2; ++j) acc[i][j] = MFMA(bfr[j], af[i], acc[i][j]);
    }
  }
}

constexpr int HTB = 128 * 64 * 2;
DI int lds_byte(int r, int c) { int st = (r >> 4) * 2 + (c >> 5), rr = r & 15, cc = c & 31, ob = rr * 64 + cc * 2; return st * 1024 + (ob ^ (((ob >> 9) & 1) << 5)); }
DI void stage_rc(int b, int& R, int& C) { int st = b / 1024, sb = b % 1024, swz = sb ^ (((sb >> 9) & 1) << 5); R = (st >> 1) * 16 + swz / 64; C = (st & 1) * 32 + (swz % 64) / 2; }
DI void gemm256(const u16* __restrict__ A, int lda, const u16* __restrict__ Bt, int ldb, int nt, LAS char* lds, f32x4 (&acc)[2][2][4][2],
                bool pre = false, const u16* __restrict__ An = nullptr, const u16* __restrict__ Bn = nullptr) {
  const int tid = ltid(), wid = __builtin_amdgcn_readfirstlane(tid >> 6), lane = tid & 63, wr = wid >> 2, wc = wid & 3, fr = lane & 15, fq = lane >> 4;
  unsigned voffA[2], voffB[2];
#pragma unroll
  for (int i = 0; i < 2; ++i) { int R, C; stage_rc(tid * 16 + i * 8192, R, C); voffA[i] = (unsigned)(R * lda + C) * 2u; voffB[i] = (unsigned)(R * ldb + C) * 2u; }
  const size_t hstepA = (size_t)128 * lda * 2, hstepB = (size_t)128 * ldb * 2;
  const unsigned ldsw = (unsigned)wid * 1024u;
  const int aoff = lds_byte(wr * 64 + fr, fq * 8), boff = lds_byte(wc * 32 + fr, fq * 8);
  const char* Ab = (const char*)A; const char* Bb = (const char*)Bt;
#define G_SA(b, h) (((b) * 2 + (h)) * HTB)
#define G_SB(b, h) ((4 + (b) * 2 + (h)) * HTB)
#define G_AP(h, kt) (Ab + (size_t)(h) * hstepA + (size_t)(kt) * 128)
#define G_BP(h, kt) (Bb + (size_t)(h) * hstepB + (size_t)(kt) * 128)
#define G_STG(bufoff, gptr, voff_) do { _Pragma("unroll") for (int _i = 0; _i < 2; ++_i) \
    __builtin_amdgcn_global_load_lds((const unsigned*)((gptr) + voff_[_i]), (LAS unsigned*)(lds + (bufoff) + ldsw + _i * 8192), 16, 0, 0); } while (0)
#define G_LDA(dst, b, h) do { _Pragma("unroll") for (int m = 0; m < 4; ++m) _Pragma("unroll") for (int k = 0; k < 2; ++k) dst[m][k] = *(const LAS bf16x8*)(lds + G_SA(b, h) + aoff + m * 2048 + k * 1024); } while (0)
#define G_LDB(dst, b, h) do { _Pragma("unroll") for (int n = 0; n < 2; ++n) _Pragma("unroll") for (int k = 0; k < 2; ++k) dst[n][k] = *(const LAS bf16x8*)(lds + G_SB(b, h) + boff + n * 2048 + k * 1024); } while (0)
#define G_MMA(ai, bj, At_, Bt_) do { __builtin_amdgcn_s_setprio(1); _Pragma("unroll") for (int m = 0; m < 4; ++m) _Pragma("unroll") for (int n = 0; n < 2; ++n) _Pragma("unroll") for (int k = 0; k < 2; ++k) \
    acc[ai][bj][m][n] = __builtin_amdgcn_mfma_f32_16x16x32_bf16(At_[m][k], Bt_[n][k], acc[ai][bj][m][n], 0, 0, 0); __builtin_amdgcn_s_setprio(0); } while (0)
#define G_WV(n) asm volatile("s_waitcnt vmcnt(" #n ")" ::: "memory")
#define G_WL(n) asm volatile("s_waitcnt lgkmcnt(" #n ")" ::: "memory")
#define G_BAR __builtin_amdgcn_s_barrier()
#define G_SCHED __builtin_amdgcn_sched_barrier(0)
  float zer_ = 0.f; asm volatile("" : "+v"(zer_));
#pragma unroll
  for (int a = 0; a < 2; ++a)
#pragma unroll
    for (int b = 0; b < 2; ++b)
#pragma unroll
      for (int m = 0; m < 4; ++m)
#pragma unroll
        for (int n = 0; n < 2; ++n) acc[a][b][m][n] = (f32x4){zer_, zer_, zer_, zer_};
  bf16x8 At[4][2], B0[2][2], B1[2][2];
#define G_ISSUE7() do { G_STG(G_SB(0, 0), G_BP(0, 0), voffB); G_STG(G_SA(0, 0), G_AP(0, 0), voffA); G_STG(G_SB(0, 1), G_BP(1, 0), voffB); G_STG(G_SA(0, 1), G_AP(1, 0), voffA); \
    G_STG(G_SB(1, 0), G_BP(0, 1), voffB); G_STG(G_SA(1, 0), G_AP(0, 1), voffA); G_STG(G_SB(1, 1), G_BP(1, 1), voffB); } while (0)
  if (!pre) { G_WV(0); G_WL(0); G_BAR; G_ISSUE7(); }
  if (wr == 1) G_BAR;
  G_WV(10); G_BAR;
  G_WV(6); G_BAR;
  for (int t = 0; t < nt - 2; t += 2) {
    G_LDB(B0, 0, 0); G_SCHED; G_LDA(At, 0, 0); G_STG(G_SA(1, 1), G_AP(1, t + 1), voffA);
    G_WL(8); G_BAR; G_WL(0); G_MMA(0, 0, At, B0); G_BAR; G_SCHED;
    G_LDB(B1, 0, 1); G_STG(G_SB(0, 0), G_BP(0, t + 2), voffB);
    G_BAR; G_WL(0); G_MMA(0, 1, At, B1); G_BAR;
    G_LDA(At, 0, 1); G_STG(G_SA(0, 0), G_AP(0, t + 2), voffA);
    G_BAR; G_WL(0); G_MMA(1, 0, At, B0); G_BAR; G_SCHED;
    G_STG(G_SB(0, 1), G_BP(1, t + 2), voffB);
    G_WV(6); G_BAR; G_MMA(1, 1, At, B1); G_BAR;
    G_LDB(B0, 1, 0); G_SCHED; G_LDA(At, 1, 0); G_STG(G_SA(0, 1), G_AP(1, t + 2), voffA);
    G_WL(8); G_BAR; G_WL(0); G_MMA(0, 0, At, B0); G_BAR; G_SCHED;
    G_LDB(B1, 1, 1); G_STG(G_SB(1, 0), G_BP(0, t + 3), voffB);
    G_BAR; G_WL(0); G_MMA(0, 1, At, B1); G_BAR;
    G_LDA(At, 1, 1); G_STG(G_SA(1, 0), G_AP(0, t + 3), voffA);
    G_BAR; G_WL(0); G_MMA(1, 0, At, B0); G_BAR; G_SCHED;
    G_STG(G_SB(1, 1), G_BP(1, t + 3), voffB);
    G_WV(6); G_BAR; G_MMA(1, 1, At, B1); G_BAR;
  }
  { G_LDB(B0, 0, 0); G_LDA(At, 0, 0); G_STG(G_SA(1, 1), G_AP(1, nt - 1), voffA);
    G_BAR; G_WL(0); G_MMA(0, 0, At, B0); G_BAR;
    G_LDB(B1, 0, 1); G_BAR; G_WL(0); G_MMA(0, 1, At, B1); G_BAR;
    G_LDA(At, 0, 1); G_WV(4); G_BAR; G_WL(0); G_MMA(1, 0, At, B0); G_MMA(1, 1, At, B1); G_BAR; }
  { G_LDB(B0, 1, 0); G_LDA(At, 1, 0); G_WV(2); G_BAR; G_WL(0); G_MMA(0, 0, At, B0); G_BAR;
    G_LDB(B1, 1, 1); G_WV(0); G_BAR; G_WL(0); G_MMA(0, 1, At, B1); G_BAR;
    G_LDA(At, 1, 1); G_BAR; G_WL(0); G_MMA(1, 0, At, B0); G_MMA(1, 1, At, B1); G_BAR; }
  if (wr == 0) G_BAR;
  if (An != nullptr) { Ab = (const char*)An; Bb = (const char*)Bn; G_ISSUE7(); }
}
#define G_FOREACH(acc, ...) do { \
  _Pragma("unroll") for (int ai = 0; ai < 2; ++ai) _Pragma("unroll") for (int bj = 0; bj < 2; ++bj) \
  _Pragma("unroll") for (int m = 0; m < 4; ++m) _Pragma("unroll") for (int n = 0; n < 2; ++n) { \
    const int f0 = ai * 128 + wr * 64 + m * 16 + fq * 4, tok = bj * 128 + wc * 32 + n * 16 + fr; const f32x4 v = acc[ai][bj][m][n]; __VA_ARGS__ } } while (0)
#define G_LANE_IDS const int tid = ltid(), wid = tid >> 6, lane = tid & 63, wr = wid >> 2, wc = wid & 3, fr = lane & 15, fq = lane >> 4;

DI void rope_block(f32x16& v, int h, int pos, const float2* __restrict__ ropetab) {
  const int rowp = pos >> 6, colp = pos & 63;
#pragma unroll
  for (int g = 0; g < 2; ++g)
#pragma unroll
    for (int i = 0; i < 4; ++i) {
      const int f = 8 * g + 4 * h + i;
      const float2 cs = (f < 8) ? ropetab[rowp * 8 + f] : ropetab[colp * 8 + (f - 8)];
      const float x1 = v[4 * g + i], x2 = v[4 * (g + 2) + i];
      v[4 * g + i] = x1 * cs.x - x2 * cs.y;
      v[4 * (g + 2) + i] = x1 * cs.y + x2 * cs.x;
    }
}

DI void prep_transpose_tile(const float* __restrict__ W, int ldn, int k0, int n0, int nlimit, u16* __restrict__ Wt, int ldk, int ndst0, int kdst0,
                            const float* __restrict__ rowscale, char* lds) {
  float* t = (float*)lds;
  const int tid = ltid() & 255;
  __syncthreads();
#pragma unroll
  for (int it = 0; it < 16; ++it) {
    int i = (tid >> 6) + 4 * it, j = tid & 63;
    float v = 0.f;
    if (n0 + j < nlimit) v = W[(size_t)(k0 + i) * ldn + n0 + j];
    if (rowscale) v *= rowscale[k0 + i];
    t[i * 65 + j] = v;
  }
  __syncthreads();
#pragma unroll
  for (int it = 0; it < 16; ++it) {
    int j = (tid >> 6) + 4 * it, i = tid & 63;
    if (n0 + j < nlimit) Wt[(size_t)(ndst0 + j) * ldk + kdst0 + i] = f2bf(t[i * 65 + j]);
  }
}

DI void phase_prep(const Params& p, char* lds) {
  const int tid = ltid() & 255, G = vgrid(), bid = vbid();
  u16* Win = (u16*)(p.ws + OFF_WIN); u16* Wuq = (u16*)(p.ws + OFF_WUQ); u16* Wukv = (u16*)(p.ws + OFF_WUKV);
  u16* Wo = (u16*)(p.ws + OFF_WO); u16* W1 = (u16*)(p.ws + OFF_W1); u16* W2 = (u16*)(p.ws + OFF_W2);
  {
    const float4* xs = (const float4*)p.x; float4* xd = (float4*)p.out;
    for (size_t i = (size_t)bid * 256 + tid; i < (size_t)NLAT * DM / 4; i += (size_t)G * 256) xd[i] = xs[i];
    const float4* cs = (const float4*)p.ctx; float4* cd = (float4*)(p.ws + OFF_XRC);
    for (size_t i = (size_t)bid * 256 + tid; i < (size_t)NCTX * DM / 4; i += (size_t)G * 256) cd[i] = cs[i];
  }
  for (int e = bid * 256 + tid; e < NLAYER * 1024 * 16; e += G * 256) { const int row = e >> 4, c = e & 15; unsigned z_ = 0u; asm volatile("" : "+v"(z_)); *(uint4*)(Wukv + (size_t)row * 256 + 128 + c * 8) = make_uint4(z_, z_, z_, z_); }
  {
    u16* A1 = (u16*)(p.ws + OFF_A1T); u16* A2 = (u16*)(p.ws + OFF_A2T); u16* A3 = (u16*)(p.ws + OFF_A3T);
    float2* TW = (float2*)(p.ws + OFF_TW); float2* RP = (float2*)(p.ws + OFF_ROPE);
    for (int e = bid * 256 + tid; e < 256 * 256; e += G * 256) {
      int m = e >> 8, k = e & 255; int ro = (m >> 5) & 1, k1 = (m >> 6) * 32 + (m & 31), ri = k >> 7, n1 = k & 127;
      float ang = (float)((n1 * k1) & 127) / 64.f; float c = cospif(ang), s = sinpif(ang);
      float v = (ro == 0) ? (ri == 0 ? c : s) : (ri == 0 ? -s : c);
      A1[e] = f2bf(v);
    }
    for (int e = bid * 256 + tid; e < 128 * 256; e += G * 256) {
      int k2 = e >> 8, k = e & 255; int ri = k >> 7, n2 = k & 127;
      float ang = (float)((n2 * k2) & 127) / 64.f;
      A2[e] = f2bf(ri ? sinpif(ang) : cospif(ang));
    }
    for (int e = bid * 256 + tid; e < 256 * 512; e += G * 256) {
      int kk = e >> 9, k = e & 511; int ri = k >> 8, n = k & 255;
      float ang = (float)((n * kk) & 255) / 128.f;
      A3[e] = f2bf(ri ? sinpif(ang) : cospif(ang));
    }
    for (int e = bid * 256 + tid; e < 16384; e += G * 256) { float ang = (float)e / 8192.f; TW[e] = make_float2(cospif(ang), sinpif(ang)); }
    for (int e = bid * 256 + tid; e < 256 * 8; e += G * 256) {
      int pos = e >> 3, j = e & 7;
      const float invt[8] = {1.f, 0.31622776601683794f, 0.1f, 0.031622776601683794f, 0.01f, 0.0031622776601683794f, 0.001f, 0.00031622776601683794f};
      float inv = j == 0 ? invt[0] : j == 1 ? invt[1] : j == 2 ? invt[2] : j == 3 ? invt[3] : j == 4 ? invt[4] : j == 5 ? invt[5] : j == 6 ? invt[6] : invt[7];
      float angf = (float)pos * inv;
      double tt = (double)angf * 0.15915494309189535;
      tt -= floor(tt);
      float a2 = (float)(2.0 * tt);
      RP[e] = make_float2(cospif(a2), sinpif(a2));
    }
  }
  {
    float* sl = (float*)lds;
    float* part = sl + 3 * 1024;
    float* modo = (float*)(p.ws + OFF_MOD);
    const int lane = tid & 63, wave = tid >> 6;
    for (int it = bid; it < NLAYER * 96; it += G) {
      const int l = it / 96, cgp = it % 96;
      __syncthreads();
      for (int e = tid; e < 3 * 1024; e += 256) {
        int mi = e >> 10, k = e & 1023; float v = mi < 2 ? p.c[mi * 1024 + k] : p.c_ctx[k];
        sl[e] = v * sigmoidf_(v);
      }
      __syncthreads();
      const int j = cgp * 64 + lane;
      const float* wp = p.w_mod + ((size_t)l * 1024 + wave * 256) * 6144 + j;
      float a0 = 0.f, a1 = 0.f, a2 = 0.f;
#pragma unroll 8
      for (int k = 0; k < 256; ++k) {
        float w = wp[(size_t)k * 6144];
        a0 += sl[wave * 256 + k] * w; a1 += sl[1024 + wave * 256 + k] * w; a2 += sl[2048 + wave * 256 + k] * w;
      }
      part[(wave * 3 + 0) * 64 + lane] = a0; part[(wave * 3 + 1) * 64 + lane] = a1; part[(wave * 3 + 2) * 64 + lane] = a2;
      __syncthreads();
      if (tid < 192) {
        int mi = tid >> 6, ln = tid & 63;
        float s = part[(0 * 3 + mi) * 64 + ln] + part[(1 * 3 + mi) * 64 + ln] + part[(2 * 3 + mi) * 64 + ln] + part[(3 * 3 + mi) * 64 + ln];
        int jj = cgp * 64 + ln;
        modo[(size_t)(l * 3 + mi) * 6144 + jj] = s + p.b_mod[l * 6144 + jj];
      }
    }
  }
  {
    constexpr int T_IN = 16 * 15, T_UQ = 4 * 12, T_UKV = 2 * 16, T_O = 8 * 16, T_1 = 16 * 64, T_2 = 64 * 16;
    constexpr int T_L = T_IN + T_UQ + T_UKV + T_O + T_1 + T_2;
    for (int it = bid; it < NLAYER * T_L; it += G) {
      const int l = it / T_L; int t = it % T_L;
      if (t < T_IN) { int kt = t / 15, nt = t % 15;
        prep_transpose_tile(p.w_in + (size_t)l * DM * 1184, 1184, kt * 64, 256 + nt * 64, 1184, Win + (size_t)l * NINP * DM, DM, 512 + nt * 64, kt * 64, nullptr, lds); continue; }
      t -= T_IN;
      if (t < T_UQ) { int kt = t / 12, nt = t % 12;
        prep_transpose_tile(p.w_uq + (size_t)l * 256 * 768, 768, kt * 64, nt * 64, 768, Wuq + (size_t)l * 768 * 256, 256, nt * 64, kt * 64, p.q_norm_g + l * 256, lds); continue; }
      t -= T_UQ;
      if (t < T_UKV) { int kt = t / 16, nt = t % 16;
        prep_transpose_tile(p.w_ukv + (size_t)l * 128 * 1024, 1024, kt * 64, nt * 64, 1024, Wukv + (size_t)l * 1024 * 256, 256, nt * 64, kt * 64, p.kv_norm_g + l * 128, lds); continue; }
      t -= T_UKV;
      if (t < T_O) { int kt = t / 16, nt = t % 16;
        prep_transpose_tile(p.w_o + (size_t)l * DM * DM, DM, 256 + kt * 64, nt * 64, DM, Wo + (size_t)l * DM * DM, DM, nt * 64, 256 + kt * 64, nullptr, lds); continue; }
      t -= T_O;
      if (t < T_1) { int kt = t / 64, nt = t % 64;
        prep_transpose_tile(p.w_mlp1 + (size_t)l * DM * DFF, DFF, kt * 64, nt * 64, DFF, W1 + (size_t)l * DFF * DM, DM, nt * 64, kt * 64, nullptr, lds); continue; }
      t -= T_1;
      { int kt = t / 16, nt = t % 16;
        prep_transpose_tile(p.w_mlp2 + (size_t)l * DFF * DM, DM, kt * 64, nt * 64, DM, W2 + (size_t)l * DM * DFF, DFF, nt * 64, kt * 64, nullptr, lds); }
    }
  }
  {
    float* Ws = (float*)lds;
    float* ct = Ws + 64 * 65;
    float* st = ct + 64;
    for (int it = bid; it < NLAYER * 4 * 16; it += G) {
      const int l = it >> 6, g = (it >> 4) & 3, kt = it & 15;
      __syncthreads();
      if (tid < 64) { float ang = (float)tid / 32.f; ct[tid] = cospif(ang); st[tid] = sinpif(ang); }
#pragma unroll
      for (int i = 0; i < 16; ++i) { int e = tid + 256 * i; int kk = e >> 6, c = e & 63; Ws[kk * 65 + c] = p.w_in[((size_t)l * DM + kt * 64 + kk) * 1184 + g * 64 + c]; }
      __syncthreads();
      const int kk = tid & 63;
      for (int mm = 0; mm < 16; ++mm) {
        const int m = (tid >> 6) + 4 * mm;
        float sr = 0.f, si = 0.f;
        for (int c = 0; c < 64; ++c) { float w = Ws[kk * 65 + c]; int q = (m * c) & 63; sr += w * ct[q]; si -= w * st[q]; }
        u16* dst = Win + (size_t)l * NINP * DM + (size_t)(g * 64 + m) * DM + kt * 64 + kk;
        dst[0] = f2bf(sr); dst[(size_t)256 * DM] = f2bf(si);
      }
    }
  }
  {
    float* Ps = (float*)lds;
    float* Qs = Ps + 32 * 68;
    const int ty = tid >> 4, tx = tid & 15;
    for (int it = bid; it < NLAYER * 2 * 4 * 16; it += G) {
      const int l = it >> 7, wh = (it >> 6) & 1, kt = (it >> 4) & 3, nt = it & 15;
      const float* P = (wh ? p.w_pw2 : p.w_fourier) + (size_t)l * 256 * 256;
      const float* Qm = p.w_o + (size_t)l * DM * DM + (size_t)(wh ? 768 : 0) * DM;
      float acc[4][4];
#pragma unroll
      for (int a = 0; a < 4; ++a)
#pragma unroll
        for (int b = 0; b < 4; ++b) acc[a][b] = 0.f;
      for (int j0 = 0; j0 < 256; j0 += 32) {
        __syncthreads();
#pragma unroll
        for (int i = 0; i < 8; ++i) { int e = tid + 256 * i; int kk = e >> 5, jj = e & 31; Ps[jj * 68 + kk] = P[(size_t)(kt * 64 + kk) * 256 + j0 + jj]; }
#pragma unroll
        for (int i = 0; i < 8; ++i) { int e = tid + 256 * i; int jj = e >> 6, nn = e & 63; Qs[jj * 64 + nn] = Qm[(size_t)(j0 + jj) * DM + nt * 64 + nn]; }
        __syncthreads();
#pragma unroll 8
        for (int jj = 0; jj < 32; ++jj) {
          const float4 a4 = *(const float4*)&Ps[jj * 68 + ty * 4]; const float4 b4 = *(const float4*)&Qs[jj * 64 + tx * 4];
          const float av[4] = {a4.x, a4.y, a4.z, a4.w}, bv[4] = {b4.x, b4.y, b4.z, b4.w};
#pragma unroll
          for (int a = 0; a < 4; ++a)
#pragma unroll
            for (int b = 0; b < 4; ++b) acc[a][b] += av[a] * bv[b];
        }
      }
#pragma unroll
      for (int b = 0; b < 4; ++b) {
        const int n = nt * 64 + tx * 4 + b, k = (wh ? 768 : 0) + kt * 64 + ty * 4;
        *(u32x2*)(Wo + (size_t)l * DM * DM + (size_t)n * DM + k) = pack4(acc[0][b], acc[1][b], acc[2][b], acc[3][b]);
      }
    }
  }
}

DI void phase_norm(const Params& p, int l, int which, char* lds_all) {
  const int tid = ltid(), lane = tid & 63, wave = tid >> 6;
  const float* g = (which ? p.norm2_g : p.norm1_g) + l * DM;
  u16* H = (u16*)(p.ws + OFF_H);
  float* cA = (float*)lds_all; float* cB = cA + 3 * 1024;
  __syncthreads();
  for (int e = tid; e < 3 * 1024; e += 512) {
    const int mi = e >> 10, c = e & 1023;
    cA[e] = g[c] * (1.f + modp(p, l, mi, which ? 4 : 1)[c]);
    cB[e] = modp(p, l, mi, which ? 3 : 0)[c];
  }
  __syncthreads();
  const int RS = gridDim.x * 8;
  const int NR = (which == 1 && l == NLAYER - 1) ? NLAT : NT;
  const int nslab = which ? (l < NLAYER - 1 ? 4 : 0) : (l > 0 ? 8 : 0);
  const float* sgate = which ? modp(p, l, 2, 2) : modp(p, l > 0 ? l - 1 : 0, 2, 5);
  for (int row0 = blockIdx.x * 8 + wave; row0 < NR; row0 += RS * 4) {
    float4 v[4][4]; float ss[4];
#pragma unroll
    for (int k = 0; k < 4; ++k) {
      const int row = row0 + k * RS;
      if (row < NR) {
        float* xr = xrow(p, row);
#pragma unroll
        for (int i = 0; i < 4; ++i) v[k][i] = *(const float4*)(xr + i * 256 + lane * 4);
        if (row >= NLAT && nslab > 0) {
          const float* sb = (const float*)(p.ws + OFF_SLAB) + (size_t)(row - NLAT) * DM;
#pragma unroll
          for (int i = 0; i < 4; ++i) {
            const int c = i * 256 + lane * 4;
            float4 a = make_float4(0.f, 0.f, 0.f, 0.f);
            for (int kc = 0; kc < nslab; ++kc) { const float4 t4 = *(const float4*)(sb + (size_t)kc * NCTX * DM + c); a.x += t4.x; a.y += t4.y; a.z += t4.z; a.w += t4.w; }
            const float4 gt = *(const float4*)(sgate + c);
            v[k][i].x += gt.x * a.x; v[k][i].y += gt.y * a.y; v[k][i].z += gt.z * a.z; v[k][i].w += gt.w * a.w;
            *(float4*)(xr + c) = v[k][i];
          }
        }
      } else {
#pragma unroll
        for (int i = 0; i < 4; ++i) v[k][i] = make_float4(0.f, 0.f, 0.f, 0.f);
      }
    }
#pragma unroll
    for (int k = 0; k < 4; ++k) {
      float a = 0.f;
#pragma unroll
      for (int i = 0; i < 4; ++i) a += v[k][i].x * v[k][i].x + v[k][i].y * v[k][i].y + v[k][i].z * v[k][i].z + v[k][i].w * v[k][i].w;
      ss[k] = wave_sum(a);
    }
#pragma unroll
    for (int k = 0; k < 4; ++k) {
      const int row = row0 + k * RS;
      if (row < NR) {
        const float rinv = rsqrtf(ss[k] * (1.f / DM) + EPS);
        const int mi = mod_index(row);
        if (which == 0 && lane < 2) ((float*)(p.ws + OFF_SSQ))[(size_t)row * 2 + lane] = 0.f;
#pragma unroll
        for (int i = 0; i < 4; ++i) {
          const int c = i * 256 + lane * 4;
          const float4 a4 = *(const float4*)(cA + mi * 1024 + c), b4 = *(const float4*)(cB + mi * 1024 + c);
          *(u32x2*)(H + (size_t)row * DM + c) = pack4(v[k][i].x * rinv * a4.x + b4.x, v[k][i].y * rinv * a4.y + b4.y,
                                                     v[k][i].z * rinv * a4.z + b4.z, v[k][i].w * rinv * a4.w + b4.w);
        }
      }
    }
  }
}

DI void phase_win(const Params& p, int l, LAS char* lds) {
  const u16* Win = (const u16*)(p.ws + OFF_WIN) + (size_t)l * NINP * DM;
  const u16* H = (const u16*)(p.ws + OFF_H);
  u16* Z = (u16*)(p.ws + OFF_Z); u16* Kb = (u16*)(p.ws + OFF_K);
  const float2* RP = (const float2*)(p.ws + OFF_ROPE);
  for (int t = blockIdx.x; t < (NT / 256) * 6; t += gridDim.x) {
    const int tt = t / 6, ft = t % 6;
    const int tn = t + gridDim.x; const bool hn = tn < (NT / 256) * 6;
    f32x4 acc[2][2][4][2];
    gemm256(Win + (size_t)ft * 256 * DM, DM, H + (size_t)tt * 256 * DM, DM, DM / 64, lds, acc, t != (int)blockIdx.x,
            hn ? Win + (size_t)(tn % 6) * 256 * DM : nullptr, hn ? H + (size_t)(tn / 6) * 256 * DM : nullptr);
    G_LANE_IDS
    G_FOREACH(acc, {
      const int F = ft * 256 + f0, T = tt * 256 + tok;
      if (F < 896 || (F >= 928 && F < ZW)) *(u32x2*)(Z + (size_t)T * ZW + F) = pack4(v[0], v[1], v[2], v[3]);
    });
    if (ft == 2 || ft == 3) {
      float* ssq = (float*)(p.ws + OFF_SSQ);
#pragma unroll
      for (int bj = 0; bj < 2; ++bj)
#pragma unroll
        for (int n = 0; n < 2; ++n) {
          float a = 0.f;
#pragma unroll
          for (int ai = 0; ai < 2; ++ai)
#pragma unroll
            for (int m = 0; m < 4; ++m) {
              if (ft == 3 && ai == 1) continue;
              const f32x4 v = acc[ai][bj][m][n];
              a += v[0] * v[0] + v[1] * v[1] + v[2] * v[2] + v[3] * v[3];
            }
          a += shx(a, 16); a += shx(a, 32);
          if (fq == 0) atomicAdd(ssq + (size_t)(tt * 256 + bj * 128 + wc * 32 + n * 16 + fr) * 2 + (ft - 2), a);
        }
    }
    if (ft == 3 && wr == 0) {
#pragma unroll
      for (int bj = 0; bj < 2; ++bj)
#pragma unroll
        for (int n = 0; n < 2; ++n) {
          const int T = tt * 256 + bj * 128 + wc * 32 + n * 16 + fr;
          int b, key, pos; bool lat; tok_info(T, b, key, lat, pos);
          f32x4 x1 = acc[1][bj][0][n], x2 = acc[1][bj][1][n];
          if (lat) {
            const int rowp = pos >> 6, colp = pos & 63;
#pragma unroll
            for (int j = 0; j < 4; ++j) {
              const int i = fq * 4 + j;
              const float2 cs = (i < 8) ? RP[rowp * 8 + i] : RP[colp * 8 + (i - 8)];
              const float a = x1[j], c = x2[j];
              x1[j] = a * cs.x - c * cs.y; x2[j] = a * cs.y + c * cs.x;
            }
          }
          const u32x2 p1 = pack4(x1[0], x1[1], x1[2], x1[3]), p2 = pack4(x2[0], x2[1], x2[2], x2[3]);
#pragma unroll
          for (int hh = 0; hh < NH; ++hh) {
            u16* kd = Kb + ((size_t)(b * NH + hh) * NKEYS + key) * 96 + 64 + fq * 4;
            *(u32x2*)kd = p1; *(u32x2*)(kd + 16) = p2;
          }
        }
    }
  }
}

DI void mid_up256(const Params& p, int l, int t, int tn, LAS char* lds) {
  const u16* Zb = (const u16*)(p.ws + OFF_Z);
  const float* ssq = (const float*)(p.ws + OFF_SSQ);
  f32x4 acc[2][2][4][2];
  const bool isq = t < (NT / 256) * 3;
  const int u = isq ? t : t - (NT / 256) * 3;
  const int tt = isq ? u / 3 : u / 4, ft = isq ? u % 3 : u % 4;
  auto ptrs = [&](int ti, const u16*& a_, const u16*& b_) {
    const bool q_ = ti < (NT / 256) * 3; const int u_ = q_ ? ti : ti - (NT / 256) * 3; const int tt_ = q_ ? u_ / 3 : u_ / 4, ft_ = q_ ? u_ % 3 : u_ % 4;
    a_ = (q_ ? (const u16*)(p.ws + OFF_WUQ) + (size_t)l * 768 * 256 : (const u16*)(p.ws + OFF_WUKV) + (size_t)l * 1024 * 256) + (size_t)ft_ * 256 * 256;
    b_ = Zb + (size_t)tt_ * 256 * ZW + (q_ ? 512 : 768); };
  const u16* a0; const u16* b0; ptrs(t, a0, b0);
  const u16* a1 = nullptr; const u16* b1 = nullptr; if (tn >= 0) ptrs(tn, a1, b1);
  gemm256(a0, 256, b0, ZW, 4, lds, acc, t != (int)blockIdx.x, a1, b1);
  G_LANE_IDS
  if (isq) {
    u16* Q = (u16*)(p.ws + OFF_Q);
    const float2* RP = (const float2*)(p.ws + OFF_ROPE);
#pragma unroll
    for (int bj = 0; bj < 2; ++bj)
#pragma unroll
      for (int n = 0; n < 2; ++n) {
        const int T = tt * 256 + bj * 128 + wc * 32 + n * 16 + fr;
        const float sc = rsqrtf(ssq[(size_t)T * 2] * (1.f / 256.f) + EPS) * QSCALE;
        const bool lat = T < NLAT;
        const int pos = T & (SEQ - 1), rowp = pos >> 6, colp = pos & 63;
#pragma unroll
        for (int ai = 0; ai < 2; ++ai)
#pragma unroll
          for (int mp = 0; mp < 4; mp += 2) {
            f32x4 x1 = acc[ai][bj][mp][n] * sc, x2 = acc[ai][bj][mp + 1][n] * sc;
            const int b16 = ft * 16 + ai * 8 + wr * 4 + mp;
            if ((b16 % 6) == 4 && lat) {
#pragma unroll
              for (int j = 0; j < 4; ++j) {
                const int i = fq * 4 + j;
                const float2 cs = (i < 8) ? RP[rowp * 8 + i] : RP[colp * 8 + (i - 8)];
                const float a = x1[j], c = x2[j];
                x1[j] = a * cs.x - c * cs.y; x2[j] = a * cs.y + c * cs.x;
              }
            }
            u16* qd = Q + (size_t)T * 768 + b16 * 16 + fq * 4;
            *(u32x2*)qd = pack4(x1[0], x1[1], x1[2], x1[3]);
            *(u32x2*)(qd + 16) = pack4(x2[0], x2[1], x2[2], x2[3]);
          }
      }
  } else {
    u16* Kb = (u16*)(p.ws + OFF_K); u16* Vt = (u16*)(p.ws + OFF_VT);
#pragma unroll
    for (int bj = 0; bj < 2; ++bj)
#pragma unroll
      for (int n = 0; n < 2; ++n) {
        const int T = tt * 256 + bj * 128 + wc * 32 + n * 16 + fr;
        const float sc = rsqrtf(ssq[(size_t)T * 2 + 1] * (1.f / 128.f) + EPS);
        int b, key, pos; bool lat; tok_info(T, b, key, lat, pos);
        const int kp = vpos(key);
#pragma unroll
        for (int ai = 0; ai < 2; ++ai) {
          const int hh = ft * 2 + ai;
#pragma unroll
          for (int m = 0; m < 4; ++m) {
            const f32x4 v = acc[ai][bj][m][n] * sc;
            const int within = wr * 64 + m * 16 + fq * 4;
            if (wr == 0) {
              *(u32x2*)(Kb + ((size_t)(b * NH + hh) * NKEYS + key) * 96 + within) = pack4(v[0], v[1], v[2], v[3]);
            } else {
              u16* vd = Vt + ((size_t)(b * NH + hh) * 64 + (within - 64)) * NKEYS + kp;
              vd[0] = f2bf(v[0]); vd[NKEYS] = f2bf(v[1]); vd[2 * NKEYS] = f2bf(v[2]); vd[3 * NKEYS] = f2bf(v[3]);
            }
          }
        }
      }
  }
}
DI void mid_conv(const Params& p, int l, int it, char* lds) {
  const int tid = ltid() & 255, lane = tid & 63, wave = tid >> 6;
  const int row0 = it * 32;
  int seqbase, n0, N;
  if (row0 < NLAT) { seqbase = row0 & ~(SEQ - 1); n0 = row0 & (SEQ - 1); N = SEQ; }
  else { int rr = row0 - NLAT; seqbase = NLAT + (rr & ~255); n0 = rr & 255; N = CTXL; }
  const u16* Z = (const u16*)(p.ws + OFF_Z);
  u16* CAT = (u16*)(p.ws + OFF_CAT);
  float* us = (float*)lds;
  const int c = tid;
  __syncthreads();
#pragma unroll 1
  for (int r0 = 0; r0 < 64; r0 += 8) {
    u16 av[8], gv[8];
#pragma unroll
    for (int k = 0; k < 8; ++k) {
      int n = n0 - 15 + r0 + k; n = n < 0 ? 0 : (n >= N ? N - 1 : n);
      const u16* zr = Z + (size_t)(seqbase + n) * ZW;
      av[k] = zr[928 + c]; gv[k] = zr[1184 + c];
    }
    __builtin_amdgcn_sched_barrier(0);
#pragma unroll
    for (int k = 0; k < 8; ++k) {
      const int rr = r0 + k, n = n0 - 15 + rr;
      const float a = bf2f(av[k]), g = bf2f(gv[k]);
      const float u = (n >= 0 && n < N) ? a * sigmoidf_(g) : 0.f;
      if (rr < 62) us[rr * 256 + c] = u;
    }
  }
  float w[31];
#pragma unroll
  for (int j = 0; j < 31; ++j) w[j] = p.w_dw[((size_t)l * 31 + j) * 256 + c];
  const float bias = p.b_dw[l * 256 + c];
#pragma unroll 1
  for (int t0 = 0; t0 < 32; t0 += 8) {
    float acc[8];
#pragma unroll
    for (int o = 0; o < 8; ++o) acc[o] = bias;
#pragma unroll
    for (int rr = 0; rr < 38; ++rr) {
      const float u = us[(t0 + rr) * 256 + c];
#pragma unroll
      for (int o = 0; o < 8; ++o) { const int j = rr - o; if (j >= 0 && j < 31) acc[o] += w[j] * u; }
    }
#pragma unroll
    for (int o = 0; o < 8; ++o) us[(t0 + o) * 256 + c] = acc[o];
  }
  __syncthreads();
  const float4 lg = *(const float4*)(p.conv_ln_g + l * 256 + lane * 4), lb = *(const float4*)(p.conv_ln_b + l * 256 + lane * 4);
#pragma unroll
  for (int tt = 0; tt < 8; ++tt) {
    const int t = wave * 8 + tt;
    const float4 x = *(const float4*)(us + t * 256 + lane * 4);
    const float mu = wave_sum(x.x + x.y + x.z + x.w) * (1.f / 256.f);
    const float d0 = x.x - mu, d1 = x.y - mu, d2 = x.z - mu, d3 = x.w - mu;
    const float var = wave_sum(d0 * d0 + d1 * d1 + d2 * d2 + d3 * d3) * (1.f / 256.f);
    const float ri = rsqrtf(var + EPS);
    float y0 = d0 * ri * lg.x + lb.x, y1 = d1 * ri * lg.y + lb.y, y2 = d2 * ri * lg.z + lb.z, y3 = d3 * ri * lg.w + lb.w;
    y0 *= sigmoidf_(y0); y1 *= sigmoidf_(y1); y2 *= sigmoidf_(y2); y3 *= sigmoidf_(y3);
    *(u32x2*)(CAT + (size_t)(row0 + t) * DM + 768 + lane * 4) = pack4(y0, y1, y2, y3);
  }
}
DI void mid_fft1(const Params& p, int t, char* lds) {
  const int tid = ltid() & 255, lane = tid & 63, wave = tid >> 6, r = lane & 31, h = lane >> 5, wa = wave >> 1, wb = wave & 1;
  const int ntile = t & 1, mt = (t >> 1) & 1, n2 = (t >> 2) & 127, b = t >> 9;
  const u16* A1 = (const u16*)(p.ws + OFF_A1T) + (size_t)mt * 128 * 256;
  const u16* Z = (const u16*)(p.ws + OFF_Z);
  u16* Y = (u16*)(p.ws + OFF_Y);
  const float2* TW = (const float2*)(p.ws + OFF_TW);
  f32x16 acc[2][2]; float rinv[2];
  gemm128<1, false>(A1, 256, [&](int k) { return Z + (size_t)(b * SEQ + 128 * (k & 127) + n2) * ZW + (k >> 7) * 256 + ntile * 128; }, 256, lds, acc, rinv);
  {
    const int k1 = mt * 64 + wa * 32 + r;
    const float2 tw = TW[n2 * k1];
    u16* yrow = Y + ((size_t)(b * 128 + k1) * 128 + n2) * 512;
#pragma unroll
    for (int j = 0; j < 2; ++j)
#pragma unroll
      for (int g = 0; g < 4; ++g) {
        const int ch = ntile * 128 + wb * 64 + j * 32 + 8 * g + 4 * h;
        float re[4], im[4];
#pragma unroll
        for (int e = 0; e < 4; ++e) { const float yr = acc[0][j][4 * g + e], yi = acc[1][j][4 * g + e]; re[e] = yr * tw.x + yi * tw.y; im[e] = yi * tw.x - yr * tw.y; }
        *(u32x2*)(yrow + ch) = pack4(re[0], re[1], re[2], re[3]);
        *(u32x2*)(yrow + 256 + ch) = pack4(im[0], im[1], im[2], im[3]);
      }
  }
}
DI void mid_ctxdft(const Params& p, int t, char* lds) {
  const int tid = ltid() & 255, lane = tid & 63, wave = tid >> 6, r = lane & 31, h = lane >> 5, wa = wave >> 1, wb = wave & 1;
  const int ntile = t & 1, mt = (t >> 1) & 1, b = t >> 2;
  const u16* A3 = (const u16*)(p.ws + OFF_A3T) + (size_t)mt * 128 * 512;
  const u16* Z = (const u16*)(p.ws + OFF_Z);
  u16* CAT = (u16*)(p.ws + OFF_CAT);
  f32x16 acc[2][2]; float rinv[2];
  gemm128<1, false>(A3, 512, [&](int k) { return Z + (size_t)(NLAT + b * 256 + (k & 255)) * ZW + (k >> 8) * 256 + ntile * 128; }, 512, lds, acc, rinv);
#pragma unroll
  for (int i = 0; i < 2; ++i) {
    const int kk = mt * 128 + wa * 64 + i * 32 + r;
    u16* crow_ = CAT + (size_t)(NLAT + b * 256 + kk) * DM;
#pragma unroll
    for (int j = 0; j < 2; ++j)
#pragma unroll
      for (int g = 0; g < 4; ++g) {
        const int ch = ntile * 128 + wb * 64 + j * 32 + 8 * g + 4 * h;
        *(u32x2*)(crow_ + ch) = pack4(acc[i][j][4 * g] * (1.f / 128.f), acc[i][j][4 * g + 1] * (1.f / 128.f), acc[i][j][4 * g + 2] * (1.f / 128.f), acc[i][j][4 * g + 3] * (1.f / 128.f));
      }
  }
}
constexpr int N_UP256 = (NT / 256) * 7, N_CONV = NT / 32, N_FFT1 = 2 * 128 * 4, N_CDFT = 8;
DI void phase_mid(const Params& p, int l, char* lds, LAS char* lds3) {
  for (int it = blockIdx.x; it < N_UP256; it += gridDim.x) mid_up256(p, l, it, (it + (int)gridDim.x < N_UP256) ? it + (int)gridDim.x : -1, lds3);
  __syncthreads();
  for (int it = vbid(); it < N_CONV + N_FFT1 + N_CDFT; it += vgrid()) {
    int t = it;
    if (t < N_CDFT) { mid_ctxdft(p, t, lds); continue; }
    t -= N_CDFT;
    if (t < N_FFT1) { mid_fft1(p, t, lds); continue; }
    t -= N_FFT1;
    mid_conv(p, l, t, lds);
  }
}

DI void attn_fft2(const Params& p, int t, char* lds) {
  const int tid = ltid() & 255, lane = tid & 63, wave = tid >> 6, r = lane & 31, h = lane >> 5, wa = wave >> 1, wb = wave & 1;
  const int ntile = t & 1, k1 = (t >> 1) & 127, b = t >> 8;
  const u16* A2 = (const u16*)(p.ws + OFF_A2T);
  const u16* Y = (const u16*)(p.ws + OFF_Y);
  u16* CAT = (u16*)(p.ws + OFF_CAT);
  f32x16 acc[2][2]; float rinv[2];
  gemm128<1, false>(A2, 256, [&](int k) { return Y + ((size_t)(b * 128 + k1) * 128 + (k & 127)) * 512 + (k >> 7) * 256 + ntile * 128; }, 256, lds, acc, rinv);
#pragma unroll
  for (int i = 0; i < 2; ++i) {
    const int k2 = wa * 64 + i * 32 + r;
    u16* crow_ = CAT + (size_t)(b * SEQ + k1 + 128 * k2) * DM;
#pragma unroll
    for (int j = 0; j < 2; ++j)
#pragma unroll
      for (int g = 0; g < 4; ++g) {
        const int ch = ntile * 128 + wb * 64 + j * 32 + 8 * g + 4 * h;
        *(u32x2*)(crow_ + ch) = pack4(acc[i][j][4 * g] * (1.f / 1024.f), acc[i][j][4 * g + 1] * (1.f / 1024.f), acc[i][j][4 * g + 2] * (1.f / 1024.f), acc[i][j][4 * g + 3] * (1.f / 1024.f));
      }
  }
}
constexpr int AST = 40960;
DI void attn8(const u16* __restrict__ Qp, const u16* __restrict__ Kp, const u16* __restrict__ Vp, int nkeys, u16* __restrict__ Op, LAS char* lds) {
  const int tid = ltid(), wid = __builtin_amdgcn_readfirstlane(tid >> 6), lane = tid & 63, r = lane & 31, h = lane >> 5;
  bf16x8 qf[6];
  {
    const u16* qrow = Qp + (size_t)(wid * 32 + r) * 768 + 8 * h;
#pragma unroll
    for (int s = 0; s < 6; ++s) qf[s] = *(const bf16x8*)(qrow + 16 * s);
  }
  const char* src[5];
#pragma unroll
  for (int i = 0; i < 5; ++i) {
    const int pce = wid * 5 + i;
    if (pce < 24) {
      const int byte = pce * 1024 + lane * 16, row = byte / 192, sl = (byte % 192) >> 4;
      src[i] = (const char*)Kp + row * 192 + ((sl ^ ((row >> 2) & 3)) << 4);
    } else {
      const int hv = (pce - 24) >> 3, byte = ((pce - 24) & 7) * 1024 + lane * 16, d = byte >> 7, sl = (byte & 127) >> 4;
      src[i] = (const char*)Vp + (size_t)d * (NKEYS * 2) + hv * 128 + ((sl ^ ((d >> 1) & 7)) << 4);
    }
  }
  auto issue = [&](int slot) {
#pragma unroll
    for (int i = 0; i < 5; ++i) {
      const int pce = wid * 5 + i;
      __builtin_amdgcn_global_load_lds((const unsigned*)src[i], (LAS unsigned*)(lds + slot * AST + pce * 1024), 16, 0, 0);
      src[i] += (pce < 24) ? 128 * 192 : 256;
    }
  };
  const int x2 = (r >> 2) & 3, y3 = (r >> 1) & 7;
  const int ko_e = r * 192 + ((h ^ x2) << 4), ko_o = r * 192 + (((2 + h) ^ x2) << 4);
  int vo[4];
#pragma unroll
  for (int sl = 0; sl < 4; ++sl) vo[sl] = r * 128 + (((2 * sl + h) ^ y3) << 4);
  f32x16 o0, o1;
#pragma unroll
  for (int q = 0; q < 16; ++q) { o0[q] = 0.f; o1[q] = 0.f; }
  float m_run = 0.f, l_run = 0.f;
  f32x16 negm;
#pragma unroll
  for (int q = 0; q < 16; ++q) negm[q] = 0.f;
  const int NST = nkeys / 128;
  asm volatile("s_waitcnt vmcnt(0) lgkmcnt(0)" ::: "memory");
  __builtin_amdgcn_s_barrier();
  issue(0);
  if (NST > 1) issue(1);
  int slot = 0;
  for (int t = 0; t < NST; ++t) {
    if (t + 1 < NST) asm volatile("s_waitcnt vmcnt(5)" ::: "memory"); else asm volatile("s_waitcnt vmcnt(0)" ::: "memory");
    __builtin_amdgcn_s_barrier();
    __builtin_amdgcn_sched_barrier(0);
    if (t + 2 < NST) { int s2 = slot + 2; if (s2 >= 3) s2 -= 3; issue(s2); }
    __builtin_amdgcn_sched_barrier(0);
    LAS const char* Sb = lds + slot * AST;
#pragma unroll
    for (int hv = 0; hv < 2; ++hv) {
      f32x16 s0, s1;
      bf16x8 ka0[6], ka1[6];
#pragma unroll
      for (int s = 0; s < 6; ++s) {
        const int ko = (s & 1) ? ko_o : ko_e;
        ka0[s] = *(const LAS bf16x8*)(Sb + (hv * 64) * 192 + (s >> 1) * 64 + ko);
        ka1[s] = *(const LAS bf16x8*)(Sb + (hv * 64 + 32) * 192 + (s >> 1) * 64 + ko);
      }
      __builtin_amdgcn_sched_barrier(0);
      s0 = MFMA(ka0[0], qf[0], negm); s1 = MFMA(ka1[0], qf[0], negm);
#pragma unroll
      for (int s = 1; s < 6; ++s) { s0 = MFMA(ka0[s], qf[s], s0); s1 = MFMA(ka1[s], qf[s], s1); }
      LAS const char* Vb = Sb + 24576 + hv * 8192;
      bf16x8 vf0[4], vf1[4];
#pragma unroll
      for (int sl = 0; sl < 4; ++sl) { vf0[sl] = *(const LAS bf16x8*)(Vb + vo[sl]); vf1[sl] = *(const LAS bf16x8*)(Vb + 32 * 128 + vo[sl]); }
      __builtin_amdgcn_sched_barrier(0);
      float mt_ = s0[0];
#pragma unroll
      for (int q = 1; q < 16; ++q) mt_ = fmaxf(mt_, s0[q]);
#pragma unroll
      for (int q = 0; q < 16; ++q) mt_ = fmaxf(mt_, s1[q]);
      mt_ = swap_max(mt_);
      const bool first = (hv == 0) && (t == 0);
      if (first || !__all(mt_ <= 8.f)) {
        const float delta = first ? mt_ : fmaxf(mt_, 0.f);
        const float alpha = first ? 1.f : __builtin_amdgcn_exp2f(-delta);
        m_run += delta;
        l_run *= alpha;
#pragma unroll
        for (int q = 0; q < 16; ++q) { o0[q] *= alpha; o1[q] *= alpha; s0[q] -= delta; s1[q] -= delta; negm[q] = -m_run; }
      }
      float ps = 0.f;
#pragma unroll
      for (int q = 0; q < 16; ++q) { s0[q] = __builtin_amdgcn_exp2f(s0[q]); ps += s0[q]; }
#pragma unroll
      for (int q = 0; q < 16; ++q) { s1[q] = __builtin_amdgcn_exp2f(s1[q]); ps += s1[q]; }
      l_run += ps;
      bf16x8 pf[4];
      {
        u32x4 w;
        w[0] = cvtpk(s0[0], s0[1]); w[1] = cvtpk(s0[2], s0[3]); w[2] = cvtpk(s0[4], s0[5]); w[3] = cvtpk(s0[6], s0[7]); pf[0] = __builtin_bit_cast(bf16x8, w);
        w[0] = cvtpk(s0[8], s0[9]); w[1] = cvtpk(s0[10], s0[11]); w[2] = cvtpk(s0[12], s0[13]); w[3] = cvtpk(s0[14], s0[15]); pf[1] = __builtin_bit_cast(bf16x8, w);
        w[0] = cvtpk(s1[0], s1[1]); w[1] = cvtpk(s1[2], s1[3]); w[2] = cvtpk(s1[4], s1[5]); w[3] = cvtpk(s1[6], s1[7]); pf[2] = __builtin_bit_cast(bf16x8, w);
        w[0] = cvtpk(s1[8], s1[9]); w[1] = cvtpk(s1[10], s1[11]); w[2] = cvtpk(s1[12], s1[13]); w[3] = cvtpk(s1[14], s1[15]); pf[3] = __builtin_bit_cast(bf16x8, w);
      }
#pragma unroll
      for (int sl = 0; sl < 4; ++sl) { o0 = MFMA(vf0[sl], pf[sl], o0); o1 = MFMA(vf1[sl], pf[sl], o1); }
    }
    slot = (slot == 2) ? 0 : slot + 1;
  }
  const float linv = 1.f / swap_sum(l_run);
  u16* orow = Op + (size_t)(wid * 32 + r) * DM;
#pragma unroll
  for (int g = 0; g < 4; ++g) {
    *(u32x2*)(orow + 8 * g + 4 * h) = pack4(o0[4 * g] * linv, o0[4 * g + 1] * linv, o0[4 * g + 2] * linv, o0[4 * g + 3] * linv);
    *(u32x2*)(orow + 32 + 8 * g + 4 * h) = pack4(o1[4 * g] * linv, o1[4 * g + 1] * linv, o1[4 * g + 2] * linv, o1[4 * g + 3] * linv);
  }
}
constexpr int N_FFT2 = 2 * 128 * 2, N_ACTX = 2 * NH, N_ALAT = 2 * NH * 64;
DI void phase_attn(const Params& p, char* lds, LAS char* lds3) {
  const u16* Q = (const u16*)(p.ws + OFF_Q); const u16* Kb = (const u16*)(p.ws + OFF_K); const u16* Vt = (const u16*)(p.ws + OFF_VT);
  u16* CAT = (u16*)(p.ws + OFF_CAT);
  for (int it = vbid(); it < N_FFT2; it += vgrid()) attn_fft2(p, it, lds);
  __syncthreads();
  for (int it = blockIdx.x; it < N_ACTX + N_ALAT; it += gridDim.x) {
    int t = it;
    if (t < N_ACTX) {
      const int hh = t & 7, b = t >> 3;
      const int row0 = NLAT + b * 256;
      attn8(Q + (size_t)row0 * 768 + hh * 96, Kb + (size_t)(b * NH + hh) * NKEYS * 96, Vt + (size_t)(b * NH + hh) * 64 * NKEYS, CTXL,
            CAT + (size_t)row0 * DM + 256 + hh * 64, lds3);
      continue;
    }
    t -= N_ACTX;
    {
      const int qt = t & 63, hh = (t >> 6) & 7, b = t >> 9;
      const int row0 = b * SEQ + qt * 256;
      attn8(Q + (size_t)row0 * 768 + hh * 96, Kb + (size_t)(b * NH + hh) * NKEYS * 96, Vt + (size_t)(b * NH + hh) * 64 * NKEYS, NKEYS,
            CAT + (size_t)row0 * DM + 256 + hh * 64, lds3);
    }
  }
}

template <int KFULL, int KS>
DI void resid_gemm_phase(const Params& p, int l, const u16* __restrict__ W, const u16* __restrict__ X, int gate_chunk, LAS char* lds) {
  constexpr int NWHOLE = (NLAT / 256) * 4, KC = KFULL / KS;
  const int nitems = NWHOLE + ((l == NLAYER - 1) ? 0 : 8 * KS);
  float* slab = (float*)(p.ws + OFF_SLAB);
  for (int t = blockIdx.x; t < nitems; t += gridDim.x) {
    f32x4 acc[2][2][4][2];
    const bool split = t >= NWHOLE;
    auto tile_of = [&](int ti, int& tile_, int& kc_) {
      const int u_ = ti - NWHOLE, bx = ti & 7, bs = (ti & 255) >> 3, rnd = ti >> 8;
      tile_ = ti >= NWHOLE ? NWHOLE + u_ / KS : (rnd * 64 + bx * 8 + (bs >> 2)) * 4 + (bs & 3); kc_ = ti >= NWHOLE ? u_ % KS : 0; };
    int tile, kc; tile_of(t, tile, kc);
    const int tt = tile / 4, ft = tile % 4;
    const int tn = t + gridDim.x; const bool hn = tn < nitems;
    int tile_n = 0, kc_n = 0; if (hn) tile_of(tn, tile_n, kc_n);
    gemm256(W + (size_t)ft * 256 * KFULL + kc * KC, KFULL, X + (size_t)tt * 256 * KFULL + kc * KC, KFULL, split ? KC / 64 : KFULL / 64, lds, acc, t != (int)blockIdx.x,
            hn ? W + (size_t)(tile_n % 4) * 256 * KFULL + kc_n * KC : nullptr, hn ? X + (size_t)(tile_n / 4) * 256 * KFULL + kc_n * KC : nullptr);
    G_LANE_IDS
    if (split) {
      float* sb = slab + (size_t)kc * NCTX * DM;
      G_FOREACH(acc, {
        const int F = ft * 256 + f0, T = tt * 256 + tok - NLAT;
        *(float4*)(sb + (size_t)T * DM + F) = make_float4(v[0], v[1], v[2], v[3]);
      });
    } else {
      const float* gate = modp(p, l, mod_index(tt * 256), gate_chunk);
      G_FOREACH(acc, {
        const int F = ft * 256 + f0, T = tt * 256 + tok;
        float* xr = xrow(p, T) + F;
        const float4 gt = *(const float4*)(gate + F);
        float4 xv = *(float4*)xr;
        xv.x += gt.x * v[0]; xv.y += gt.y * v[1]; xv.z += gt.z * v[2]; xv.w += gt.w * v[3];
        *(float4*)xr = xv;
      });
    }
  }
}
constexpr int KS_WO = 4, KS_M2 = 8;
DI void phase_wo(const Params& p, int l, LAS char* lds) {
  resid_gemm_phase<DM, KS_WO>(p, l, (const u16*)(p.ws + OFF_WO) + (size_t)l * DM * DM, (const u16*)(p.ws + OFF_CAT), 2, lds);
}
DI void phase_mlp1(const Params& p, int l, LAS char* lds) {
  const u16* W1 = (const u16*)(p.ws + OFF_W1) + (size_t)l * DFF * DM;
  const u16* H = (const u16*)(p.ws + OFF_H);
  u16* A1 = (u16*)(p.ws + OFF_A1);
  const int ntt = (l == NLAYER - 1) ? NLAT / 256 : NT / 256;
  for (int t = blockIdx.x; t < ntt * 16; t += gridDim.x) {
    const int tt = t / 16, ft = t % 16;
    const int tn = t + gridDim.x; const bool hn = tn < ntt * 16;
    f32x4 acc[2][2][4][2];
    gemm256(W1 + (size_t)ft * 256 * DM, DM, H + (size_t)tt * 256 * DM, DM, DM / 64, lds, acc, t != (int)blockIdx.x,
            hn ? W1 + (size_t)(tn % 16) * 256 * DM : nullptr, hn ? H + (size_t)(tn / 16) * 256 * DM : nullptr);
    G_LANE_IDS
    G_FOREACH(acc, {
      const int F = ft * 256 + f0, T = tt * 256 + tok;
      const float a = fmaxf(v[0], 0.f), b = fmaxf(v[1], 0.f), c = fmaxf(v[2], 0.f), d = fmaxf(v[3], 0.f);
      *(u32x2*)(A1 + (size_t)T * DFF + F) = pack4(a * a, b * b, c * c, d * d);
    });
  }
}
DI void phase_mlp2(const Params& p, int l, LAS char* lds) {
  resid_gemm_phase<DFF, KS_M2>(p, l, (const u16*)(p.ws + OFF_W2) + (size_t)l * DM * DFF, (const u16*)(p.ws + OFF_A1), 5, lds);
}
DI void phase_final(const Params& p) {
  const int tid = ltid(), lane = tid & 63, wave = tid >> 6;
  const int RS = gridDim.x * 8;
  float4 g4[4];
#pragma unroll
  for (int i = 0; i < 4; ++i) g4[i] = *(const float4*)(p.final_norm_g + i * 256 + lane * 4);
  for (int row0 = blockIdx.x * 8 + wave; row0 < NLAT; row0 += RS * 4) {
    float4 v[4][4]; float ss[4];
#pragma unroll
    for (int k = 0; k < 4; ++k) {
      const int row = row0 + k * RS;
      const float* xr = p.out + (size_t)(row < NLAT ? row : row0) * DM;
#pragma unroll
      for (int i = 0; i < 4; ++i) v[k][i] = *(const float4*)(xr + i * 256 + lane * 4);
    }
#pragma unroll
    for (int k = 0; k < 4; ++k) {
      float a = 0.f;
#pragma unroll
      for (int i = 0; i < 4; ++i) a += v[k][i].x * v[k][i].x + v[k][i].y * v[k][i].y + v[k][i].z * v[k][i].z + v[k][i].w * v[k][i].w;
      ss[k] = wave_sum(a);
    }
#pragma unroll
    for (int k = 0; k < 4; ++k) {
      const int row = row0 + k * RS;
      if (row < NLAT) {
        const float rinv = rsqrtf(ss[k] * (1.f / DM) + EPS);
        float* xr = p.out + (size_t)row * DM;
#pragma unroll
        for (int i = 0; i < 4; ++i)
          *(float4*)(xr + i * 256 + lane * 4) = make_float4(v[k][i].x * rinv * g4[i].x, v[k][i].y * rinv * g4[i].y, v[k][i].z * rinv * g4[i].z, v[k][i].w * rinv * g4[i].w);
      }
    }
  }
}

constexpr int N_PHASES = 2 + 8 * NLAYER;
DI void run_phase(const Params& p, int ph, char* lds_all) {
#define HLDS (lds_all + (ltid() >> 8) * 73728)
  LAS char* lds3 = (LAS char*)lds_all;
  if (ph == 0) { phase_prep(p, HLDS); return; }
  if (ph == N_PHASES - 1) { phase_final(p); return; }
  const int l = (ph - 1) >> 3, s = (ph - 1) & 7;
  switch (s) {
    case 0: phase_norm(p, l, 0, lds_all); break;
    case 1: phase_win(p, l, lds3); break;
    case 2: phase_mid(p, l, HLDS, lds3); break;
    case 3: phase_attn(p, HLDS, lds3); break;
    case 4: phase_wo(p, l, lds3); break;
    case 5: phase_norm(p, l, 1, lds_all); break;
    case 6: phase_mlp1(p, l, lds3); break;
    default: phase_mlp2(p, l, lds3); break;
  }
}

extern __shared__ __attribute__((aligned(16))) char dyn_lds[];

#ifndef DIAG
#define DIAG 0
#endif
#ifndef DIAG_A
#define DIAG_A 0x008
#endif
#ifndef DIAG_B
#define DIAG_B 0x0C0
#endif
__global__ void __launch_bounds__(512, 2) mega_kernel(Params p) {
  cg::grid_group grid = cg::this_grid();
  volatile LAS unsigned* st = (volatile LAS unsigned*)((LAS char*)dyn_lds + LDS_PHASE);
  if (threadIdx.x == 0) { st[0] = 0u; st[1] = 0u; st[2] = 0u; st[3] = 0u; }
  __syncthreads();
  (void)xcd_barrier_post((unsigned*)(p.ws + OFF_BAR), st);
#define MK_XB() XcdBarrier{(unsigned*)(p.ws + OFF_BAR), xb_xcc_id(), (volatile LAS unsigned*)((LAS char*)dyn_lds + LDS_PHASE)}
#if DIAG
  unsigned long long* TS = (unsigned long long*)(p.ws + OFF_TS);
  const bool rec = (blockIdx.x == 0 && threadIdx.x == 0);
  if (rec) TS[0] = wall_clock64();
#endif
  for (int ph = 0; ph < N_PHASES; ++ph) {
    run_phase(p, ph, dyn_lds);
#if DIAG
    if (ph == 0) grid.sync(); else xcd_barrier(MK_XB());
    if (rec) TS[ph + 1] = wall_clock64();
#else
    if (ph == 0) grid.sync(); else if (ph + 1 < N_PHASES) xcd_barrier(MK_XB());
#endif
  }
#if DIAG
  if (blockIdx.x == 0) {
    unsigned long long ta = 0, tb = 0;
    for (int ph = 0; ph < N_PHASES; ++ph) {
      const int type = ph == 0 ? 8 : (ph == N_PHASES - 1 ? 9 : ((ph - 1) & 7));
      const unsigned long long d = TS[ph + 1] - TS[ph];
      if ((DIAG_A >> type) & 1) ta += d;
      if ((DIAG_B >> type) & 1) tb += d;
    }
    const float vb = (float)tb * 0.01f * 0.00002f;
    (void)ta;
    for (int i = threadIdx.x; i < 4096; i += 512) p.out[i] += (i == 0) ? 0.f : vb;
  }
#endif
}
#if MK_MULTI
__global__ void __launch_bounds__(512, 2) phase_kernel(Params p, int ph) { run_phase(p, ph, dyn_lds); }
#endif

extern "C" void kernel_launch(void* const* d_in, const int* in_sizes, int n_in, void* d_out, int out_size, void* d_ws, size_t ws_size,
                              hipStream_t stream) {
  Params p{};
  const float** f = (const float**)&p;
  for (int i = 0; i < 23; ++i) f[i] = (const float*)d_in[i];
  p.out = (float*)d_out;
  p.ws = (char*)d_ws;
  if (ws_size < WS_TOTAL) { fprintf(stderr, "kernel_launch: ws too small: %zu < %zu\n", ws_size, (size_t)WS_NEED); return; }
  static int grid_blocks = 0;
  if (!grid_blocks) {
    (void)hipFuncSetAttribute((const void*)mega_kernel, hipFuncAttributeMaxDynamicSharedMemorySize, LDS_BYTES);
#if MK_MULTI
    (void)hipFuncSetAttribute((const void*)phase_kernel, hipFuncAttributeMaxDynamicSharedMemorySize, LDS_BYTES);
#endif
    int dev = 0, cus = 0, per_cu = 0;
    (void)hipGetDevice(&dev);
    (void)hipDeviceGetAttribute(&cus, hipDeviceAttributeMultiprocessorCount, dev);
    (void)hipOccupancyMaxActiveBlocksPerMultiprocessor(&per_cu, mega_kernel, 512, LDS_BYTES);
    if (per_cu > 1) per_cu = 1;
    if (per_cu < 1) per_cu = 1;
    grid_blocks = cus * per_cu;
  }
#if MK_MULTI
  for (int ph = 0; ph < N_PHASES; ++ph) hipLaunchKernelGGL(phase_kernel, dim3(grid_blocks), dim3(512), LDS_BYTES, stream, p, ph);
#else
  (void)hipMemsetAsync((char*)d_ws + OFF_BAR, 0, XCD_BAR_WORDS * 4, stream);
  void* args[] = {&p};
  hipError_t e = hipLaunchCooperativeKernel((void*)mega_kernel, dim3(grid_blocks), dim3(512), args, LDS_BYTES, stream);
  if (e != hipSuccess) fprintf(stderr, "cooperative launch failed: %s (grid %d)\n", hipGetErrorString(e), grid_blocks);
#endif
}
```

```cpp
#include <hip/hip_runtime.h>
#include <hip/hip_cooperative_groups.h>
#include <cstdio>
#include <cstdint>
namespace cg = cooperative_groups;

#ifndef MK_MULTI
#define MK_MULTI 0
#endif

typedef unsigned short u16;
using bf16x8 = __attribute__((ext_vector_type(8))) short;
using f32x16 = __attribute__((ext_vector_type(16))) float;
using u32x4  = __attribute__((ext_vector_type(4))) unsigned;
using u32x2  = __attribute__((ext_vector_type(2))) unsigned;
#define DI __device__ __forceinline__
#define MFMA(a, b, c) __builtin_amdgcn_mfma_f32_32x32x16_bf16((a), (b), (c), 0, 0, 0)

constexpr int DM = 1024, NLAT = 32768, NCTX = 512, NT = NLAT + NCTX, SEQ = 16384, CTXL = 256, NLAYER = 4;
constexpr int ZW = 1440, NINP = 1536, DFF = 4096, NKEYS = SEQ + CTXL, NH = 8;
constexpr int MT = NT / 128;
constexpr float EPS = 1e-6f;
constexpr float QSCALE = 0.10206207261596575f * 1.4426950408889634f;

constexpr size_t al256(size_t x) { return (x + 255) / 256 * 256; }
constexpr size_t SZ_WIN = (size_t)NLAYER * NINP * DM * 2, SZ_WUQ = (size_t)NLAYER * 768 * 256 * 2, SZ_WUKV = (size_t)NLAYER * 1024 * 256 * 2;
constexpr size_t SZ_WO = (size_t)NLAYER * DM * DM * 2, SZ_W1 = (size_t)NLAYER * DFF * DM * 2, SZ_W2 = SZ_W1;
constexpr size_t OFF_WIN = 0, OFF_WUQ = OFF_WIN + SZ_WIN, OFF_WUKV = OFF_WUQ + SZ_WUQ, OFF_WO = OFF_WUKV + SZ_WUKV;
constexpr size_t OFF_W1 = OFF_WO + SZ_WO, OFF_W2 = OFF_W1 + SZ_W1, OFF_MOD = OFF_W2 + SZ_W2;
constexpr size_t OFF_A1T = OFF_MOD + al256((size_t)NLAYER * 3 * 6144 * 4);
constexpr size_t OFF_A2T = OFF_A1T + 256 * 256 * 2, OFF_A3T = OFF_A2T + 128 * 256 * 2, OFF_TW = OFF_A3T + 256 * 512 * 2;
constexpr size_t OFF_ROPE = OFF_TW + 16384 * 8, OFF_XRC = OFF_ROPE + 256 * 8 * 8, OFF_H = OFF_XRC + (size_t)NCTX * DM * 4;
constexpr size_t OFF_UNI = OFF_H + (size_t)NT * DM * 2;
constexpr size_t OFF_Z = OFF_UNI, OFF_Q = OFF_Z + (size_t)NT * ZW * 2, OFF_K = OFF_Q + (size_t)NT * 768 * 2;
constexpr size_t OFF_VT = OFF_K + (size_t)2 * NH * NKEYS * 96 * 2, OFF_CAT = OFF_VT + (size_t)2 * NH * 64 * NKEYS * 2;
constexpr size_t OFF_Y = OFF_CAT + (size_t)NT * DM * 2, UNI_END = OFF_Y + (size_t)2 * SEQ * 512 * 2;
constexpr size_t OFF_A1 = OFF_UNI, A1_END = OFF_A1 + (size_t)NT * DFF * 2;
constexpr size_t WS_NEED = UNI_END > A1_END ? UNI_END : A1_END;
constexpr int LDS_PHASE = 2 * 73728;
constexpr int LDS_BYTES = LDS_PHASE + 16;
constexpr size_t OFF_TS = al256(WS_NEED), OFF_BAR = OFF_TS + 4096, OFF_SLAB = al256(OFF_BAR + 3456 * 4), OFF_SSQ = OFF_SLAB + (size_t)8 * NCTX * DM * 4, WS_TOTAL = OFF_SSQ + (size_t)NT * 2 * 4;

struct Params {
  const float *x, *c, *ctx, *c_ctx, *w_mod, *b_mod, *norm1_g, *w_in, *q_norm_g, *w_uq, *kv_norm_g, *w_ukv, *w_fourier, *w_dw, *b_dw,
      *conv_ln_g, *conv_ln_b, *w_pw2, *w_o, *norm2_g, *w_mlp1, *w_mlp2, *final_norm_g;
  float* out;
  char* ws;
};

DI int ltid() { int t = threadIdx.x; asm volatile("" : "+v"(t)); return t; }
DI int vbid() { int h = __builtin_amdgcn_readfirstlane((int)(threadIdx.x >> 8)); asm volatile("" : "+s"(h)); return blockIdx.x * 2 + h; }
DI int vgrid() { return gridDim.x * 2; }
#define LAS __attribute__((address_space(3)))
using f32x4 = __attribute__((ext_vector_type(4))) float;
DI int crow(int reg, int h) { return (reg & 3) + 8 * (reg >> 2) + 4 * h; }
DI unsigned cvtpk(float lo, float hi) { unsigned r; asm("v_cvt_pk_bf16_f32 %0, %1, %2" : "=v"(r) : "v"(lo), "v"(hi)); return r; }
DI u16 f2bf(float x) { return (u16)(cvtpk(x, 0.f) & 0xffffu); }
DI float bf2f(u16 v) { return __uint_as_float(((unsigned)v) << 16); }
DI u32x2 pack4(float a, float b, float c, float d) { u32x2 r; r[0] = cvtpk(a, b); r[1] = cvtpk(c, d); return r; }
DI float shx(float v, int o) { const int ln = ltid() & 63; return __builtin_bit_cast(float, __builtin_amdgcn_ds_bpermute((ln ^ o) << 2, __builtin_bit_cast(int, v))); }
DI float wave_sum(float v) {
#pragma unroll
  for (int o = 32; o; o >>= 1) v += shx(v, o);
  return v;
}
DI float swap_max(float v) {
  auto rr = __builtin_amdgcn_permlane32_swap(__float_as_uint(v), __float_as_uint(v), false, false);
  return fmaxf(__uint_as_float(rr[0]), __uint_as_float(rr[1]));
}
DI float swap_sum(float v) {
  auto rr = __builtin_amdgcn_permlane32_swap(__float_as_uint(v), __float_as_uint(v), false, false);
  return __uint_as_float(rr[0]) + __uint_as_float(rr[1]);
}
DI float sigmoidf_(float x) { return 1.f / (1.f + __expf(-x)); }
DI float* xrow(const Params& p, int row) { return row < NLAT ? p.out + (size_t)row * DM : (float*)(p.ws + OFF_XRC) + (size_t)(row - NLAT) * DM; }
DI int mod_index(int row) { return row < NLAT ? (row >> 14) : 2; }
DI const float* modp(const Params& p, int l, int mi, int chunk) { return (const float*)(p.ws + OFF_MOD) + ((size_t)(l * 3 + mi) * 6 + chunk) * 1024; }
DI void tok_info(int m, int& b, int& key, bool& lat, int& pos) {
  if (m < NLAT) { b = m >> 14; pos = m & (SEQ - 1); key = CTXL + pos; lat = true; }
  else { int mm = m - NLAT; b = mm >> 8; pos = mm & 255; key = pos; lat = false; }
}
DI int vpos(int key) { return (key & ~12) | ((key & 4) << 1) | ((key & 8) >> 1); }


#define XB_TMO      128
#define XB_XCNT(j)  (256  + 64 * (j))
#define XB_XSUB(j)  (1280 + 64 * (j))
#define XB_XGEN(j)  (2304 + 64 * (j))
#define XB_TOP      3328
#define XB_TOPGEN   3392
#define XCD_BAR_WORDS 3456
#define XB_SPIN_CAP (1u << 22)
DI unsigned xb_ld(unsigned* p) { return __hip_atomic_load(p, __ATOMIC_RELAXED, __HIP_MEMORY_SCOPE_AGENT); }
DI unsigned xb_add(unsigned* p, unsigned v) { return __hip_atomic_fetch_add(p, v, __ATOMIC_RELAXED, __HIP_MEMORY_SCOPE_AGENT); }
DI unsigned xb_xcc_id() { return (unsigned)__builtin_amdgcn_s_getreg((3 << 11) | 20) & 0xFu; }
#define XB_SPIN(cond, bar) do { unsigned _sp = 0; while (cond) { __builtin_amdgcn_s_sleep(1); \
    if ((++_sp & 255u) == 0u) { if (xb_ld(&(bar)[XB_TMO])) break; if (_sp > XB_SPIN_CAP) { atomicAdd(&(bar)[XB_TMO], 1u); break; } } } } while (0)
struct XcdBarrier { unsigned* bar; unsigned x; volatile LAS unsigned* st; };
DI XcdBarrier xcd_barrier_post(unsigned* bar, volatile LAS unsigned* st) {
  XcdBarrier b; b.bar = bar; b.x = xb_xcc_id(); b.st = st;
  if (threadIdx.x == 0) (void)xb_add(&bar[XB_XCNT(b.x)], 1u);
  return b;
}
DI void xcd_barrier_complete(unsigned* bar, unsigned x, unsigned& nloc, unsigned& nx) {
  const unsigned G = gridDim.x * gridDim.y * gridDim.z;
  unsigned sum, cnt, mine, sp = 0u;
  for (;;) {
    sum = 0u; cnt = 0u; mine = 0u;
#pragma unroll
    for (unsigned j = 0; j < 16; ++j) { const unsigned c = xb_ld(&bar[XB_XCNT(j)]); sum += c; cnt += (c > 0u) ? 1u : 0u; mine = (j == x) ? c : mine; }
    if (sum == G) break;
    __builtin_amdgcn_s_sleep(1);
    if ((++sp & 255u) == 0u) { if (xb_ld(&bar[XB_TMO])) break; if (sp > XB_SPIN_CAP) { atomicAdd(&bar[XB_TMO], 1u); break; } }
  }
  nloc = mine > 0u ? mine : 1u; nx = cnt > 0u ? cnt : 1u;
}
DI void xcd_barrier(const XcdBarrier& b) {
  asm volatile("s_waitcnt vmcnt(0)" ::: "memory");
  __syncthreads();
  if (threadIdx.x == 0) {
    unsigned* bar = b.bar;
    __builtin_amdgcn_s_waitcnt(0);
    unsigned nloc = b.st[0], nx = b.st[1];
    if (nloc == 0u) { xcd_barrier_complete(bar, b.x, nloc, nx); b.st[0] = nloc; b.st[1] = nx; }
    const unsigned old = xb_add(&bar[XB_XSUB(b.x)], 1u);
    const unsigned gen = old / nloc;
    if (old + 1u == (gen + 1u) * nloc) {
      __builtin_amdgcn_fence(__ATOMIC_RELEASE, "agent");
      asm volatile("s_waitcnt vmcnt(0)" ::: "memory");
      const unsigned og = xb_add(&bar[XB_TOP], 1u);
      const unsigned tg = og / nx;
      if (og + 1u == (tg + 1u) * nx) xb_add(&bar[XB_TOPGEN], 1u);
      else XB_SPIN(xb_ld(&bar[XB_TOPGEN]) == tg, bar);
      __builtin_amdgcn_fence(__ATOMIC_ACQUIRE, "agent");
      xb_add(&bar[XB_XGEN(b.x)], 1u);
      asm volatile("s_waitcnt vmcnt(0)" ::: "memory");
    } else {
      XB_SPIN(xb_ld(&bar[XB_XGEN(b.x)]) == gen, bar);
      __builtin_amdgcn_fence(__ATOMIC_ACQUIRE, "agent");
      asm volatile("s_waitcnt vmcnt(0)" ::: "memory");
    }
  }
  __syncthreads();
}

template <int BT, bool RMS, class BRow>
DI void gemm128(const u16* __restrict__ A, int lda, BRow brow, int K, char* lds_, f32x16 (&acc)[2][2], float (&rinv)[2]) {
  static_assert(BT == 1 && !RMS, "only the transposed-B form is used");
  const int tid = ltid() & 255, lane = tid & 63, wave = __builtin_amdgcn_readfirstlane(tid >> 6), r = lane & 31, h = lane >> 5;
  const int wa = wave >> 1, wb = wave & 1;
  LAS char* lds = (LAS char*)lds_;
#pragma unroll
  for (int i = 0; i < 2; ++i)
#pragma unroll
    for (int j = 0; j < 2; ++j)
#pragma unroll
      for (int q = 0; q < 16; ++q) acc[i][j][q] = 0.f;
  rinv[0] = rinv[1] = 1.f;
  const int KT = K / 64;
  unsigned aoff[4];
#pragma unroll
  for (int i = 0; i < 4; ++i) { const int row = (wave * 4 + i) * 8 + (lane >> 3), sl = lane & 7; aoff[i] = (unsigned)(row * lda + ((sl ^ ((row >> 1) & 7)) << 3)) * 2u; }
  auto issue = [&](int kt, int buf) {
#pragma unroll
    for (int i = 0; i < 4; ++i)
      __builtin_amdgcn_global_load_lds((const unsigned*)((const char*)A + aoff[i] + kt * 128), (LAS unsigned*)(lds + buf * 32768 + (wave * 4 + i) * 1024), 16, 0, 0);
#pragma unroll
    for (int i = 0; i < 4; ++i) {
      const int kr = (wave * 4 + i) * 4 + (lane >> 4);
      __builtin_amdgcn_global_load_lds((const unsigned*)(brow(kt * 64 + kr) + (lane & 15) * 8), (LAS unsigned*)(lds + buf * 32768 + 16384 + (wave * 4 + i) * 1024), 16, 0, 0);
    }
  };
  const int y3 = (r >> 1) & 7;
  asm volatile("s_waitcnt vmcnt(0) lgkmcnt(0)" ::: "memory");
  __builtin_amdgcn_s_barrier();
  issue(0, 0);
  for (int kt = 0; kt < KT; ++kt) {
    const int cur = kt & 1;
    asm volatile("s_waitcnt vmcnt(0)" ::: "memory");
    __builtin_amdgcn_s_barrier();
    __builtin_amdgcn_sched_barrier(0);
    if (kt + 1 < KT) issue(kt + 1, cur ^ 1);
    __builtin_amdgcn_sched_barrier(0);
    LAS const char* Ab = lds + cur * 32768 + (wa * 64 + r) * 128;
    LAS const u16* Bb = (LAS const u16*)(lds + cur * 32768 + 16384);
#pragma unroll
    for (int ks = 0; ks < 4; ++ks) {
      bf16x8 af[2], bfr[2];
#pragma unroll
      for (int i = 0; i < 2; ++i) af[i] = *(const LAS bf16x8*)(Ab + i * 32 * 128 + (((2 * ks + h) ^ y3) << 4));
#pragma unroll
      for (int j = 0; j < 2; ++j)
#pragma unroll
        for (int q = 0; q < 8; ++q) bfr[j][q] = (short)Bb[(ks * 16 + 8 * h + q) * 128 + wb * 64 + j * 32 + r];
#pragma unroll
      for (int i = 0; i < 2; ++i)
#pragma unroll
        for (int j = 0; j < 2; ++j) acc[i][j] = MFMA(bfr[j], af[i], acc[i][j]);
    }
  }
}

constexpr int HTB = 128 * 64 * 2;
DI int lds_byte(int r, int c) { int st = (r >> 4) * 2 + (c >> 5), rr = r & 15, cc = c & 31, ob = rr * 64 + cc * 2; return st * 1024 + (ob ^ (((ob >> 9) & 1) << 5)); }
DI void stage_rc(int b, int& R, int& C) { int st = b / 1024, sb = b % 1024, swz = sb ^ (((sb >> 9) & 1) << 5); R = (st >> 1) * 16 + swz / 64; C = (st & 1) * 32 + (swz % 64) / 2; }
DI void gemm256(const u16* __restrict__ A, int lda, const u16* __restrict__ Bt, int ldb, int nt, LAS char* lds, f32x4 (&acc)[2][2][4][2],
                bool pre = false, const u16* __restrict__ An = nullptr, const u16* __restrict__ Bn = nullptr) {
  const int tid = ltid(), wid = __builtin_amdgcn_readfirstlane(tid >> 6), lane = tid & 63, wr = wid >> 2, wc = wid & 3, fr = lane & 15, fq = lane >> 4;
  unsigned voffA[2], voffB[2];
#pragma unroll
  for (int i = 0; i < 2; ++i) { int R, C; stage_rc(tid * 16 + i * 8192, R, C); voffA[i] = (unsigned)(R * lda + C) * 2u; voffB[i] = (unsigned)(R * ldb + C) * 2u; }
  const size_t hstepA = (size_t)128 * lda * 2, hstepB = (size_t)128 * ldb * 2;
  const unsigned ldsw = (unsigned)wid * 1024u;
  const int aoff = lds_byte(wr * 64 + fr, fq * 8), boff = lds_byte(wc * 32 + fr, fq * 8);
  const char* Ab = (const char*)A; const char* Bb = (const char*)Bt;
#define G_SA(b, h) (((b) * 2 + (h)) * HTB)
#define G_SB(b, h) ((4 + (b) * 2 + (h)) * HTB)
#define G_AP(h, kt) (Ab + (size_t)(h) * hstepA + (size_t)(kt) * 128)
#define G_BP(h, kt) (Bb + (size_t)(h) * hstepB + (size_t)(kt) * 128)
#define G_STG(bufoff, gptr, voff_) do { _Pragma("unroll") for (int _i = 0; _i < 2; ++_i) \
    __builtin_amdgcn_global_load_lds((const unsigned*)((gptr) + voff_[_i]), (LAS unsigned*)(lds + (bufoff) + ldsw + _i * 8192), 16, 0, 0); } while (0)
#define G_LDA(dst, b, h) do { _Pragma("unroll") for (int m = 0; m < 4; ++m) _Pragma("unroll") for (int k = 0; k < 2; ++k) dst[m][k] = *(const LAS bf16x8*)(lds + G_SA(b, h) + aoff + m * 2048 + k * 1024); } while (0)
#define G_LDB(dst, b, h) do { _Pragma("unroll") for (int n = 0; n < 2; ++n) _Pragma("unroll") for (int k = 0; k < 2; ++k) dst[n][k] = *(const LAS bf16x8*)(lds + G_SB(b, h) + boff + n * 2048 + k * 1024); } while (0)
#define G_MMA(ai, bj, At_, Bt_) do { __builtin_amdgcn_s_setprio(1); _Pragma("unroll") for (int m = 0; m < 4; ++m) _Pragma("unroll") for (int n = 0; n < 2; ++n) _Pragma("unroll") for (int k = 0; k < 2; ++k) \
    acc[ai][bj][m][n] = __builtin_amdgcn_mfma_f32_16x16x32_bf16(At_[m][k], Bt_[n][k], acc[ai][bj][m][n], 0, 0, 0); __builtin_amdgcn_s_setprio(0); } while (0)
#define G_WV(n) asm volatile("s_waitcnt vmcnt(" #n ")" ::: "memory")
#define G_WL(n) asm volatile("s_waitcnt lgkmcnt(" #n ")" ::: "memory")
#define G_BAR __builtin_amdgcn_s_barrier()
#define G_SCHED __builtin_amdgcn_sched_barrier(0)
  float zer_ = 0.f; asm volatile("" : "+v"(zer_));
#pragma unroll
  for (int a = 0; a < 2; ++a)
#pragma unroll
    for (int b = 0; b < 2; ++b)
#pragma unroll
      for (int m = 0; m < 4; ++m)
#pragma unroll
        for (int n = 0; n < 2; ++n) acc[a][b][m][n] = (f32x4){zer_, zer_, zer_, zer_};
  bf16x8 At[4][2], B0[2][2], B1[2][2];
#define G_ISSUE7() do { G_STG(G_SB(0, 0), G_BP(0, 0), voffB); G_STG(G_SA(0, 0), G_AP(0, 0), voffA); G_STG(G_SB(0, 1), G_BP(1, 0), voffB); G_STG(G_SA(0, 1), G_AP(1, 0), voffA); \
    G_STG(G_SB(1, 0), G_BP(0, 1), voffB); G_STG(G_SA(1, 0), G_AP(0, 1), voffA); G_STG(G_SB(1, 1), G_BP(1, 1), voffB); } while (0)
  if (!pre) { G_WV(0); G_WL(0); G_BAR; G_ISSUE7(); }
  if (wr == 1) G_BAR;
  G_WV(10); G_BAR;
  G_WV(6); G_BAR;
  for (int t = 0; t < nt - 2; t += 2) {
    G_LDB(B0, 0, 0); G_SCHED; G_LDA(At, 0, 0); G_STG(G_SA(1, 1), G_AP(1, t + 1), voffA);
    G_WL(8); G_BAR; G_WL(0); G_MMA(0, 0, At, B0); G_BAR; G_SCHED;
    G_LDB(B1, 0, 1); G_STG(G_SB(0, 0), G_BP(0, t + 2), voffB);
    G_BAR; G_WL(0); G_MMA(0, 1, At, B1); G_BAR;
    G_LDA(At, 0, 1); G_STG(G_SA(0, 0), G_AP(0, t + 2), voffA);
    G_BAR; G_WL(0); G_MMA(1, 0, At, B0); G_BAR; G_SCHED;
    G_STG(G_SB(0, 1), G_BP(1, t + 2), voffB);
    G_WV(6); G_BAR; G_MMA(1, 1, At, B1); G_BAR;
    G_LDB(B0, 1, 0); G_SCHED; G_LDA(At, 1, 0); G_STG(G_SA(0, 1), G_AP(1, t + 2), voffA);
    G_WL(8); G_BAR; G_WL(0); G_MMA(0, 0, At, B0); G_BAR; G_SCHED;
    G_LDB(B1, 1, 1); G_STG(G_SB(1, 0), G_BP(0, t + 3), voffB);
    G_BAR; G_WL(0); G_MMA(0, 1, At, B1); G_BAR;
    G_LDA(At, 1, 1); G_STG(G_SA(1, 0), G_AP(0, t + 3), voffA);
    G_BAR; G_WL(0); G_MMA(1, 0, At, B0); G_BAR; G_SCHED;
    G_STG(G_SB(1, 1), G_BP(1, t + 3), voffB);
    G_WV(6); G_BAR; G_MMA(1, 1, At, B1); G_BAR;
  }
  { G_LDB(B0, 0, 0); G_LDA(At, 0, 0); G_STG(G_SA(1, 1), G_AP(1, nt - 1), voffA);
    G_BAR; G_WL(0); G_MMA(0, 0, At, B0); G_BAR;
    G_LDB(B1, 0, 1); G_BAR; G_WL(0); G_MMA(0, 1, At, B1); G_BAR;
    G_LDA(At, 0, 1); G_WV(4); G_BAR; G_WL(0); G_MMA(1, 0, At, B0); G_MMA(1, 1, At, B1); G_BAR; }
  { G_LDB(B0, 1, 0); G_LDA(At, 1, 0); G_WV(2); G_BAR; G_WL(0); G_MMA(0, 0, At, B0); G_BAR;
    G_LDB(B1, 1, 1); G_WV(0); G_BAR; G_WL(0); G_MMA(0, 1, At, B1); G_BAR;
    G_LDA(At, 1, 1); G_BAR; G_WL(0); G_MMA(1, 0, At, B0); G_MMA(1, 1, At, B1); G_BAR; }
  if (wr == 0) G_BAR;
  if (An != nullptr) { Ab = (const char*)An; Bb = (const char*)Bn; G_ISSUE7(); }
}
#define G_FOREACH(acc, ...) do { \
  _Pragma("unroll") for (int ai = 0; ai < 2; ++ai) _Pragma("unroll") for (int bj = 0; bj < 2; ++bj) \
  _Pragma("unroll") for (int m = 0; m < 4; ++m) _Pragma("unroll") for (int n = 0; n < 2; ++n) { \
    const int f0 = ai * 128 + wr * 64 + m * 16 + fq * 4, tok = bj * 128 + wc * 32 + n * 16 + fr; const f32x4 v = acc[ai][bj][m][n]; __VA_ARGS__ } } while (0)
#define G_LANE_IDS const int tid = ltid(), wid = tid >> 6, lane = tid & 63, wr = wid >> 2, wc = wid & 3, fr = lane & 15, fq = lane >> 4;

DI void rope_block(f32x16& v, int h, int pos, const float2* __restrict__ ropetab) {
  const int rowp = pos >> 6, colp = pos & 63;
#pragma unroll
  for (int g = 0; g < 2; ++g)
#pragma unroll
    for (int i = 0; i < 4; ++i) {
      const int f = 8 * g + 4 * h + i;
      const float2 cs = (f < 8) ? ropetab[rowp * 8 + f] : ropetab[colp * 8 + (f - 8)];
      const float x1 = v[4 * g + i], x2 = v[4 * (g + 2) + i];
      v[4 * g + i] = x1 * cs.x - x2 * cs.y;
      v[4 * (g + 2) + i] = x1 * cs.y + x2 * cs.x;
    }
}

DI void prep_transpose_tile(const float* __restrict__ W, int ldn, int k0, int n0, int nlimit, u16* __restrict__ Wt, int ldk, int ndst0, int kdst0,
                            const float* __restrict__ rowscale, char* lds) {
  float* t = (float*)lds;
  const int tid = ltid() & 255;
  __syncthreads();
#pragma unroll
  for (int it = 0; it < 16; ++it) {
    int i = (tid >> 6) + 4 * it, j = tid & 63;
    float v = 0.f;
    if (n0 + j < nlimit) v = W[(size_t)(k0 + i) * ldn + n0 + j];
    if (rowscale) v *= rowscale[k0 + i];
    t[i * 65 + j] = v;
  }
  __syncthreads();
#pragma unroll
  for (int it = 0; it < 16; ++it) {
    int j = (tid >> 6) + 4 * it, i = tid & 63;
    if (n0 + j < nlimit) Wt[(size_t)(ndst0 + j) * ldk + kdst0 + i] = f2bf(t[i * 65 + j]);
  }
}

DI void phase_prep(const Params& p, char* lds) {
  const int tid = ltid() & 255, G = vgrid(), bid = vbid();
  u16* Win = (u16*)(p.ws + OFF_WIN); u16* Wuq = (u16*)(p.ws + OFF_WUQ); u16* Wukv = (u16*)(p.ws + OFF_WUKV);
  u16* Wo = (u16*)(p.ws + OFF_WO); u16* W1 = (u16*)(p.ws + OFF_W1); u16* W2 = (u16*)(p.ws + OFF_W2);
  {
    const float4* xs = (const float4*)p.x; float4* xd = (float4*)p.out;
    for (size_t i = (size_t)bid * 256 + tid; i < (size_t)NLAT * DM / 4; i += (size_t)G * 256) xd[i] = xs[i];
    const float4* cs = (const float4*)p.ctx; float4* cd = (float4*)(p.ws + OFF_XRC);
    for (size_t i = (size_t)bid * 256 + tid; i < (size_t)NCTX * DM / 4; i += (size_t)G * 256) cd[i] = cs[i];
  }
  for (int e = bid * 256 + tid; e < NLAYER * 1024 * 16; e += G * 256) { const int row = e >> 4, c = e & 15; unsigned z_ = 0u; asm volatile("" : "+v"(z_)); *(uint4*)(Wukv + (size_t)row * 256 + 128 + c * 8) = make_uint4(z_, z_, z_, z_); }
  {
    u16* A1 = (u16*)(p.ws + OFF_A1T); u16* A2 = (u16*)(p.ws + OFF_A2T); u16* A3 = (u16*)(p.ws + OFF_A3T);
    float2* TW = (float2*)(p.ws + OFF_TW); float2* RP = (float2*)(p.ws + OFF_ROPE);
    for (int e = bid * 256 + tid; e < 256 * 256; e += G * 256) {
      int m = e >> 8, k = e & 255; int ro = (m >> 5) & 1, k1 = (m >> 6) * 32 + (m & 31), ri = k >> 7, n1 = k & 127;
      float ang = (float)((n1 * k1) & 127) / 64.f; float c = cospif(ang), s = sinpif(ang);
      float v = (ro == 0) ? (ri == 0 ? c : s) : (ri == 0 ? -s : c);
      A1[e] = f2bf(v);
    }
    for (int e = bid * 256 + tid; e < 128 * 256; e += G * 256) {
      int k2 = e >> 8, k = e & 255; int ri = k >> 7, n2 = k & 127;
      float ang = (float)((n2 * k2) & 127) / 64.f;
      A2[e] = f2bf(ri ? sinpif(ang) : cospif(ang));
    }
    for (int e = bid * 256 + tid; e < 256 * 512; e += G * 256) {
      int kk = e >> 9, k = e & 511; int ri = k >> 8, n = k & 255;
      float ang = (float)((n * kk) & 255) / 128.f;
      A3[e] = f2bf(ri ? sinpif(ang) : cospif(ang));
    }
    for (int e = bid * 256 + tid; e < 16384; e += G * 256) { float ang = (float)e / 8192.f; TW[e] = make_float2(cospif(ang), sinpif(ang)); }
    for (int e = bid * 256 + tid; e < 256 * 8; e += G * 256) {
      int pos = e >> 3, j = e & 7;
      const float invt[8] = {1.f, 0.31622776601683794f, 0.1f, 0.031622776601683794f, 0.01f, 0.0031622776601683794f, 0.001f, 0.00031622776601683794f};
      float inv = j == 0 ? invt[0] : j == 1 ? invt[1] : j == 2 ? invt[2] : j == 3 ? invt[3] : j == 4 ? invt[4] : j == 5 ? invt[5] : j == 6 ? invt[6] : invt[7];
      float angf = (float)pos * inv;
      double tt = (double)angf * 0.15915494309189535;
      tt -= floor(tt);
      float a2 = (float)(2.0 * tt);
      RP[e] = make_float2(cospif(a2), sinpif(a2));
    }
  }
  {
    float* sl = (float*)lds;
    float* part = sl + 3 * 1024;
    float* modo = (float*)(p.ws + OFF_MOD);
    const int lane = tid & 63, wave = tid >> 6;
    for (int it = bid; it < NLAYER * 96; it += G) {
      const int l = it / 96, cgp = it % 96;
      __syncthreads();
      for (int e = tid; e < 3 * 1024; e += 256) {
        int mi = e >> 10, k = e & 1023; float v = mi < 2 ? p.c[mi * 1024 + k] : p.c_ctx[k];
        sl[e] = v * sigmoidf_(v);
      }
      __syncthreads();
      const int j = cgp * 64 + lane;
      const float* wp = p.w_mod + ((size_t)l * 1024 + wave * 256) * 6144 + j;
      float a0 = 0.f, a1 = 0.f, a2 = 0.f;
#pragma unroll 8
      for (int k = 0; k < 256; ++k) {
        float w = wp[(size_t)k * 6144];
        a0 += sl[wave * 256 + k] * w; a1 += sl[1024 + wave * 256 + k] * w; a2 += sl[2048 + wave * 256 + k] * w;
      }
      part[(wave * 3 + 0) * 64 + lane] = a0; part[(wave * 3 + 1) * 64 + lane] = a1; part[(wave * 3 + 2) * 64 + lane] = a2;
      __syncthreads();
      if (tid < 192) {
        int mi = tid >> 6, ln = tid & 63;
        float s = part[(0 * 3 + mi) * 64 + ln] + part[(1 * 3 + mi) * 64 + ln] + part[(2 * 3 + mi) * 64 + ln] + part[(3 * 3 + mi) * 64 + ln];
        int jj = cgp * 64 + ln;
        modo[(size_t)(l * 3 + mi) * 6144 + jj] = s + p.b_mod[l * 6144 + jj];
      }
    }
  }
  {
    constexpr int T_IN = 16 * 15, T_UQ = 4 * 12, T_UKV = 2 * 16, T_O = 8 * 16, T_1 = 16 * 64, T_2 = 64 * 16;
    constexpr int T_L = T_IN + T_UQ + T_UKV + T_O + T_1 + T_2;
    for (int it = bid; it < NLAYER * T_L; it += G) {
      const int l = it / T_L; int t = it % T_L;
      if (t < T_IN) { int kt = t / 15, nt = t % 15;
        prep_transpose_tile(p.w_in + (size_t)l * DM * 1184, 1184, kt * 64, 256 + nt * 64, 1184, Win + (size_t)l * NINP * DM, DM, 512 + nt * 64, kt * 64, nullptr, lds); continue; }
      t -= T_IN;
      if (t < T_UQ) { int kt = t / 12, nt = t % 12;
        prep_transpose_tile(p.w_uq + (size_t)l * 256 * 768, 768, kt * 64, nt * 64, 768, Wuq + (size_t)l * 768 * 256, 256, nt * 64, kt * 64, p.q_norm_g + l * 256, lds); continue; }
      t -= T_UQ;
      if (t < T_UKV) { int kt = t / 16, nt = t % 16;
        prep_transpose_tile(p.w_ukv + (size_t)l * 128 * 1024, 1024, kt * 64, nt * 64, 1024, Wukv + (size_t)l * 1024 * 256, 256, nt * 64, kt * 64, p.kv_norm_g + l * 128, lds); continue; }
      t -= T_UKV;
      if (t < T_O) { int kt = t / 16, nt = t % 16;
        prep_transpose_tile(p.w_o + (size_t)l * DM * DM, DM, 256 + kt * 64, nt * 64, DM, Wo + (size_t)l * DM * DM, DM, nt * 64, 256 + kt * 64, nullptr, lds); continue; }
      t -= T_O;
      if (t < T_1) { int kt = t / 64, nt = t % 64;
        prep_transpose_tile(p.w_mlp1 + (size_t)l * DM * DFF, DFF, kt * 64, nt * 64, DFF, W1 + (size_t)l * DFF * DM, DM, nt * 64, kt * 64, nullptr, lds); continue; }
      t -= T_1;
      { int kt = t / 16, nt = t % 16;
        prep_transpose_tile(p.w_mlp2 + (size_t)l * DFF * DM, DM, kt * 64, nt * 64, DM, W2 + (size_t)l * DM * DFF, DFF, nt * 64, kt * 64, nullptr, lds); }
    }
  }
  {
    float* Ws = (float*)lds;
    float* ct = Ws + 64 * 65;
    float* st = ct + 64;
    for (int it = bid; it < NLAYER * 4 * 16; it += G) {
      const int l = it >> 6, g = (it >> 4) & 3, kt = it & 15;
      __syncthreads();
      if (tid < 64) { float ang = (float)tid / 32.f; ct[tid] = cospif(ang); st[tid] = sinpif(ang); }
#pragma unroll
      for (int i = 0; i < 16; ++i) { int e = tid + 256 * i; int kk = e >> 6, c = e & 63; Ws[kk * 65 + c] = p.w_in[((size_t)l * DM + kt * 64 + kk) * 1184 + g * 64 + c]; }
      __syncthreads();
      const int kk = tid & 63;
      for (int mm = 0; mm < 16; ++mm) {
        const int m = (tid >> 6) + 4 * mm;
        float sr = 0.f, si = 0.f;
        for (int c = 0; c < 64; ++c) { float w = Ws[kk * 65 + c]; int q = (m * c) & 63; sr += w * ct[q]; si -= w * st[q]; }
        u16* dst = Win + (size_t)l * NINP * DM + (size_t)(g * 64 + m) * DM + kt * 64 + kk;
        dst[0] = f2bf(sr); dst[(size_t)256 * DM] = f2bf(si);
      }
    }
  }
  {
    float* Ps = (float*)lds;
    float* Qs = Ps + 32 * 68;
    const int ty = tid >> 4, tx = tid & 15;
    for (int it = bid; it < NLAYER * 2 * 4 * 16; it += G) {
      const int l = it >> 7, wh = (it >> 6) & 1, kt = (it >> 4) & 3, nt = it & 15;
      const float* P = (wh ? p.w_pw2 : p.w_fourier) + (size_t)l * 256 * 256;
      const float* Qm = p.w_o + (size_t)l * DM * DM + (size_t)(wh ? 768 : 0) * DM;
      float acc[4][4];
#pragma unroll
      for (int a = 0; a < 4; ++a)
#pragma unroll
        for (int b = 0; b < 4; ++b) acc[a][b] = 0.f;
      for (int j0 = 0; j0 < 256; j0 += 32) {
        __syncthreads();
#pragma unroll
        for (int i = 0; i < 8; ++i) { int e = tid + 256 * i; int kk = e >> 5, jj = e & 31; Ps[jj * 68 + kk] = P[(size_t)(kt * 64 + kk) * 256 + j0 + jj]; }
#pragma unroll
        for (int i = 0; i < 8; ++i) { int e = tid + 256 * i; int jj = e >> 6, nn = e & 63; Qs[jj * 64 + nn] = Qm[(size_t)(j0 + jj) * DM + nt * 64 + nn]; }
        __syncthreads();
#pragma unroll 8
        for (int jj = 0; jj < 32; ++jj) {
          const float4 a4 = *(const float4*)&Ps[jj * 68 + ty * 4]; const float4 b4 = *(const float4*)&Qs[jj * 64 + tx * 4];
          const float av[4] = {a4.x, a4.y, a4.z, a4.w}, bv[4] = {b4.x, b4.y, b4.z, b4.w};
#pragma unroll
          for (int a = 0; a < 4; ++a)
#pragma unroll
            for (int b = 0; b < 4; ++b) acc[a][b] += av[a] * bv[b];
        }
      }
#pragma unroll
      for (int b = 0; b < 4; ++b) {
        const int n = nt * 64 + tx * 4 + b, k = (wh ? 768 : 0) + kt * 64 + ty * 4;
        *(u32x2*)(Wo + (size_t)l * DM * DM + (size_t)n * DM + k) = pack4(acc[0][b], acc[1][b], acc[2][b], acc[3][b]);
      }
    }
  }
}

DI void phase_norm(const Params& p, int l, int which, char* lds_all) {
  const int tid = ltid(), lane = tid & 63, wave = tid >> 6;
  const float* g = (which ? p.norm2_g : p.norm1_g) + l * DM;
  u16* H = (u16*)(p.ws + OFF_H);
  float* cA = (float*)lds_all; float* cB = cA + 3 * 1024;
  __syncthreads();
  for (int e = tid; e < 3 * 1024; e += 512) {
    const int mi = e >> 10, c = e & 1023;
    cA[e] = g[c] * (1.f + modp(p, l, mi, which ? 4 : 1)[c]);
    cB[e] = modp(p, l, mi, which ? 3 : 0)[c];
  }
  __syncthreads();
  const int RS = gridDim.x * 8;
  const int NR = (which == 1 && l == NLAYER - 1) ? NLAT : NT;
  const int nslab = which ? (l < NLAYER - 1 ? 4 : 0) : (l > 0 ? 8 : 0);
  const float* sgate = which ? modp(p, l, 2, 2) : modp(p, l > 0 ? l - 1 : 0, 2, 5);
  for (int row0 = blockIdx.x * 8 + wave; row0 < NR; row0 += RS * 4) {
    float4 v[4][4]; float ss[4];
#pragma unroll
    for (int k = 0; k < 4; ++k) {
      const int row = row0 + k * RS;
      if (row < NR) {
        float* xr = xrow(p, row);
#pragma unroll
        for (int i = 0; i < 4; ++i) v[k][i] = *(const float4*)(xr + i * 256 + lane * 4);
        if (row >= NLAT && nslab > 0) {
          const float* sb = (const float*)(p.ws + OFF_SLAB) + (size_t)(row - NLAT) * DM;
#pragma unroll
          for (int i = 0; i < 4; ++i) {
            const int c = i * 256 + lane * 4;
            float4 a = make_float4(0.f, 0.f, 0.f, 0.f);
            for (int kc = 0; kc < nslab; ++kc) { const float4 t4 = *(const float4*)(sb + (size_t)kc * NCTX * DM + c); a.x += t4.x; a.y += t4.y; a.z += t4.z; a.w += t4.w; }
            const float4 gt = *(const float4*)(sgate + c);
            v[k][i].x += gt.x * a.x; v[k][i].y += gt.y * a.y; v[k][i].z += gt.z * a.z; v[k][i].w += gt.w * a.w;
            *(float4*)(xr + c) = v[k][i];
          }
        }
      } else {
#pragma unroll
        for (int i = 0; i < 4; ++i) v[k][i] = make_float4(0.f, 0.f, 0.f, 0.f);
      }
    }
#pragma unroll
    for (int k = 0; k < 4; ++k) {
      float a = 0.f;
#pragma unroll
      for (int i = 0; i < 4; ++i) a += v[k][i].x * v[k][i].x + v[k][i].y * v[k][i].y + v[k][i].z * v[k][i].z + v[k][i].w * v[k][i].w;
      ss[k] = wave_sum(a);
    }
#pragma unroll
    for (int k = 0; k < 4; ++k) {
      const int row = row0 + k * RS;
      if (row < NR) {
        const float rinv = rsqrtf(ss[k] * (1.f / DM) + EPS);
        const int mi = mod_index(row);
        if (which == 0 && lane < 2) ((float*)(p.ws + OFF_SSQ))[(size_t)row * 2 + lane] = 0.f;
#pragma unroll
        for (int i = 0; i < 4; ++i) {
          const int c = i * 256 + lane * 4;
          const float4 a4 = *(const float4*)(cA + mi * 1024 + c), b4 = *(const float4*)(cB + mi * 1024 + c);
          *(u32x2*)(H + (size_t)row * DM + c) = pack4(v[k][i].x * rinv * a4.x + b4.x, v[k][i].y * rinv * a4.y + b4.y,
                                                     v[k][i].z * rinv * a4.z + b4.z, v[k][i].w * rinv * a4.w + b4.w);
        }
      }
    }
  }
}

DI void phase_win(const Params& p, int l, LAS char* lds) {
  const u16* Win = (const u16*)(p.ws + OFF_WIN) + (size_t)l * NINP * DM;
  const u16* H = (const u16*)(p.ws + OFF_H);
  u16* Z = (u16*)(p.ws + OFF_Z); u16* Kb = (u16*)(p.ws + OFF_K);
  const float2* RP = (const float2*)(p.ws + OFF_ROPE);
  for (int t = blockIdx.x; t < (NT / 256) * 6; t += gridDim.x) {
    const int tt = t / 6, ft = t % 6;
    const int tn = t + gridDim.x; const bool hn = tn < (NT / 256) * 6;
    f32x4 acc[2][2][4][2];
    gemm256(Win + (size_t)ft * 256 * DM, DM, H + (size_t)tt * 256 * DM, DM, DM / 64, lds, acc, t != (int)blockIdx.x,
            hn ? Win + (size_t)(tn % 6) * 256 * DM : nullptr, hn ? H + (size_t)(tn / 6) * 256 * DM : nullptr);
    G_LANE_IDS
    G_FOREACH(acc, {
      const int F = ft * 256 + f0, T = tt * 256 + tok;
      if (F < 896 || (F >= 928 && F < ZW)) *(u32x2*)(Z + (size_t)T * ZW + F) = pack4(v[0], v[1], v[2], v[3]);
    });
    if (ft == 2 || ft == 3) {
      float* ssq = (float*)(p.ws + OFF_SSQ);
#pragma unroll
      for (int bj = 0; bj < 2; ++bj)
#pragma unroll
        for (int n = 0; n < 2; ++n) {
          float a = 0.f;
#pragma unroll
          for (int ai = 0; ai < 2; ++ai)
#pragma unroll
            for (int m = 0; m < 4; ++m) {
              if (ft == 3 && ai == 1) continue;
              const f32x4 v = acc[ai][bj][m][n];
              a += v[0] * v[0] + v[1] * v[1] + v[2] * v[2] + v[3] * v[3];
            }
          a += shx(a, 16); a += shx(a, 32);
          if (fq == 0) atomicAdd(ssq + (size_t)(tt * 256 + bj * 128 + wc * 32 + n * 16 + fr) * 2 + (ft - 2), a);
        }
    }
    if (ft == 3 && wr == 0) {
#pragma unroll
      for (int bj = 0; bj < 2; ++bj)
#pragma unroll
        for (int n = 0; n < 2; ++n) {
          const int T = tt * 256 + bj * 128 + wc * 32 + n * 16 + fr;
          int b, key, pos; bool lat; tok_info(T, b, key, lat, pos);
          f32x4 x1 = acc[1][bj][0][n], x2 = acc[1][bj][1][n];
          if (lat) {
            const int rowp = pos >> 6, colp = pos & 63;
#pragma unroll
            for (int j = 0; j < 4; ++j) {
              const int i = fq * 4 + j;
              const float2 cs = (i < 8) ? RP[rowp * 8 + i] : RP[colp * 8 + (i - 8)];
              const float a = x1[j], c = x2[j];
              x1[j] = a * cs.x - c * cs.y; x2[j] = a * cs.y + c * cs.x;
            }
          }
          const u32x2 p1 = pack4(x1[0], x1[1], x1[2], x1[3]), p2 = pack4(x2[0], x2[1], x2[2], x2[3]);
#pragma unroll
          for (int hh = 0; hh < NH; ++hh) {
            u16* kd = Kb + ((size_t)(b * NH + hh) * NKEYS + key) * 96 + 64 + fq * 4;
            *(u32x2*)kd = p1; *(u32x2*)(kd + 16) = p2;
          }
        }
    }
  }
}

DI void mid_up256(const Params& p, int l, int t, int tn, LAS char* lds) {
  const u16* Zb = (const u16*)(p.ws + OFF_Z);
  const float* ssq = (const float*)(p.ws + OFF_SSQ);
  f32x4 acc[2][2][4][2];
  const bool isq = t < (NT / 256) * 3;
  const int u = isq ? t : t - (NT / 256) * 3;
  const int tt = isq ? u / 3 : u / 4, ft = isq ? u % 3 : u % 4;
  auto ptrs = [&](int ti, const u16*& a_, const u16*& b_) {
    const bool q_ = ti < (NT / 256) * 3; const int u_ = q_ ? ti : ti - (NT / 256) * 3; const int tt_ = q_ ? u_ / 3 : u_ / 4, ft_ = q_ ? u_ % 3 : u_ % 4;
    a_ = (q_ ? (const u16*)(p.ws + OFF_WUQ) + (size_t)l * 768 * 256 : (const u16*)(p.ws + OFF_WUKV) + (size_t)l * 1024 * 256) + (size_t)ft_ * 256 * 256;
    b_ = Zb + (size_t)tt_ * 256 * ZW + (q_ ? 512 : 768); };
  const u16* a0; const u16* b0; ptrs(t, a0, b0);
  const u16* a1 = nullptr; const u16* b1 = nullptr; if (tn >= 0) ptrs(tn, a1, b1);
  gemm256(a0, 256, b0, ZW, 4, lds, acc, t != (int)blockIdx.x, a1, b1);
  G_LANE_IDS
  if (isq) {
    u16* Q = (u16*)(p.ws + OFF_Q);
    const float2* RP = (const float2*)(p.ws + OFF_ROPE);
#pragma unroll
    for (int bj = 0; bj < 2; ++bj)
#pragma unroll
      for (int n = 0; n < 2; ++n) {
        const int T = tt * 256 + bj * 128 + wc * 32 + n * 16 + fr;
        const float sc = rsqrtf(ssq[(size_t)T * 2] * (1.f / 256.f) + EPS) * QSCALE;
        const bool lat = T < NLAT;
        const int pos = T & (SEQ - 1), rowp = pos >> 6, colp = pos & 63;
#pragma unroll
        for (int ai = 0; ai < 2; ++ai)
#pragma unroll
          for (int mp = 0; mp < 4; mp += 2) {
            f32x4 x1 = acc[ai][bj][mp][n] * sc, x2 = acc[ai][bj][mp + 1][n] * sc;
            const int b16 = ft * 16 + ai * 8 + wr * 4 + mp;
            if ((b16 % 6) == 4 && lat) {
#pragma unroll
              for (int j = 0; j < 4; ++j) {
                const int i = fq * 4 + j;
                const float2 cs = (i < 8) ? RP[rowp * 8 + i] : RP[colp * 8 + (i - 8)];
                const float a = x1[j], c = x2[j];
                x1[j] = a * cs.x - c * cs.y; x2[j] = a * cs.y + c * cs.x;
              }
            }
            u16* qd = Q + (size_t)T * 768 + b16 * 16 + fq * 4;
            *(u32x2*)qd = pack4(x1[0], x1[1], x1[2], x1[3]);
            *(u32x2*)(qd + 16) = pack4(x2[0], x2[1], x2[2], x2[3]);
          }
      }
  } else {
    u16* Kb = (u16*)(p.ws + OFF_K); u16* Vt = (u16*)(p.ws + OFF_VT);
#pragma unroll
    for (int bj = 0; bj < 2; ++bj)
#pragma unroll
      for (int n = 0; n < 2; ++n) {
        const int T = tt * 256 + bj * 128 + wc * 32 + n * 16 + fr;
        const float sc = rsqrtf(ssq[(size_t)T * 2 + 1] * (1.f / 128.f) + EPS);
        int b, key, pos; bool lat; tok_info(T, b, key, lat, pos);
        const int kp = vpos(key);
#pragma unroll
        for (int ai = 0; ai < 2; ++ai) {
          const int hh = ft * 2 + ai;
#pragma unroll
          for (int m = 0; m < 4; ++m) {
            const f32x4 v = acc[ai][bj][m][n] * sc;
            const int within = wr * 64 + m * 16 + fq * 4;
            if (wr == 0) {
              *(u32x2*)(Kb + ((size_t)(b * NH + hh) * NKEYS + key) * 96 + within) = pack4(v[0], v[1], v[2], v[3]);
            } else {
              u16* vd = Vt + ((size_t)(b * NH + hh) * 64 + (within - 64)) * NKEYS + kp;
              vd[0] = f2bf(v[0]); vd[NKEYS] = f2bf(v[1]); vd[2 * NKEYS] = f2bf(v[2]); vd[3 * NKEYS] = f2bf(v[3]);
            }
          }
        }
      }
  }
}
DI void mid_conv(const Params& p, int l, int it, char* lds) {
  const int tid = ltid() & 255, lane = tid & 63, wave = tid >> 6;
  const int row0 = it * 32;
  int seqbase, n0, N;
  if (row0 < NLAT) { seqbase = row0 & ~(SEQ - 1); n0 = row0 & (SEQ - 1); N = SEQ; }
  else { int rr = row0 - NLAT; seqbase = NLAT + (rr & ~255); n0 = rr & 255; N = CTXL; }
  const u16* Z = (const u16*)(p.ws + OFF_Z);
  u16* CAT = (u16*)(p.ws + OFF_CAT);
  float* us = (float*)lds;
  const int c = tid;
  __syncthreads();
#pragma unroll 1
  for (int r0 = 0; r0 < 64; r0 += 32) {
    u16 av[32], gv[32];
#pragma unroll
    for (int k = 0; k < 32; ++k) {
      int n = n0 - 15 + r0 + k; n = n < 0 ? 0 : (n >= N ? N - 1 : n);
      const u16* zr = Z + (size_t)(seqbase + n) * ZW;
      av[k] = zr[928 + c]; gv[k] = zr[1184 + c];
    }
    __builtin_amdgcn_sched_barrier(0);
#pragma unroll
    for (int k = 0; k < 32; ++k) {
      const int rr = r0 + k, n = n0 - 15 + rr;
      const float a = bf2f(av[k]), g = bf2f(gv[k]);
      const float u = (n >= 0 && n < N) ? a * sigmoidf_(g) : 0.f;
      if (rr < 62) us[rr * 256 + c] = u;
    }
  }
  float w[31];
#pragma unroll
  for (int j = 0; j < 31; ++j) w[j] = p.w_dw[((size_t)l * 31 + j) * 256 + c];
  const float bias = p.b_dw[l * 256 + c];
#pragma unroll 1
  for (int t0 = 0; t0 < 32; t0 += 8) {
    float acc[8];
#pragma unroll
    for (int o = 0; o < 8; ++o) acc[o] = bias;
#pragma unroll
    for (int rr = 0; rr < 38; ++rr) {
      const float u = us[(t0 + rr) * 256 + c];
#pragma unroll
      for (int o = 0; o < 8; ++o) { const int j = rr - o; if (j >= 0 && j < 31) acc[o] += w[j] * u; }
    }
#pragma unroll
    for (int o = 0; o < 8; ++o) us[(t0 + o) * 256 + c] = acc[o];
  }
  __syncthreads();
  const float4 lg = *(const float4*)(p.conv_ln_g + l * 256 + lane * 4), lb = *(const float4*)(p.conv_ln_b + l * 256 + lane * 4);
#pragma unroll
  for (int tt = 0; tt < 8; ++tt) {
    const int t = wave * 8 + tt;
    const float4 x = *(const float4*)(us + t * 256 + lane * 4);
    const float mu = wave_sum(x.x + x.y + x.z + x.w) * (1.f / 256.f);
    const float d0 = x.x - mu, d1 = x.y - mu, d2 = x.z - mu, d3 = x.w - mu;
    const float var = wave_sum(d0 * d0 + d1 * d1 + d2 * d2 + d3 * d3) * (1.f / 256.f);
    const float ri = rsqrtf(var + EPS);
    float y0 = d0 * ri * lg.x + lb.x, y1 = d1 * ri * lg.y + lb.y, y2 = d2 * ri * lg.z + lb.z, y3 = d3 * ri * lg.w + lb.w;
    y0 *= sigmoidf_(y0); y1 *= sigmoidf_(y1); y2 *= sigmoidf_(y2); y3 *= sigmoidf_(y3);
    *(u32x2*)(CAT + (size_t)(row0 + t) * DM + 768 + lane * 4) = pack4(y0, y1, y2, y3);
  }
}
DI void mid_fft1(const Params& p, int t, char* lds) {
  const int tid = ltid() & 255, lane = tid & 63, wave = tid >> 6, r = lane & 31, h = lane >> 5, wa = wave >> 1, wb = wave & 1;
  const int ntile = t & 1, mt = (t >> 1) & 1, n2 = (t >> 2) & 127, b = t >> 9;
  const u16* A1 = (const u16*)(p.ws + OFF_A1T) + (size_t)mt * 128 * 256;
  const u16* Z = (const u16*)(p.ws + OFF_Z);
  u16* Y = (u16*)(p.ws + OFF_Y);
  const float2* TW = (const float2*)(p.ws + OFF_TW);
  f32x16 acc[2][2]; float rinv[2];
  gemm128<1, false>(A1, 256, [&](int k) { return Z + (size_t)(b * SEQ + 128 * (k & 127) + n2) * ZW + (k >> 7) * 256 + ntile * 128; }, 256, lds, acc, rinv);
  {
    const int k1 = mt * 64 + wa * 32 + r;
    const float2 tw = TW[n2 * k1];
    u16* yrow = Y + ((size_t)(b * 128 + k1) * 128 + n2) * 512;
#pragma unroll
    for (int j = 0; j < 2; ++j)
#pragma unroll
      for (int g = 0; g < 4; ++g) {
        const int ch = ntile * 128 + wb * 64 + j * 32 + 8 * g + 4 * h;
        float re[4], im[4];
#pragma unroll
        for (int e = 0; e < 4; ++e) { const float yr = acc[0][j][4 * g + e], yi = acc[1][j][4 * g + e]; re[e] = yr * tw.x + yi * tw.y; im[e] = yi * tw.x - yr * tw.y; }
        *(u32x2*)(yrow + ch) = pack4(re[0], re[1], re[2], re[3]);
        *(u32x2*)(yrow + 256 + ch) = pack4(im[0], im[1], im[2], im[3]);
      }
  }
}
DI void mid_ctxdft(const Params& p, int t, char* lds) {
  const int tid = ltid() & 255, lane = tid & 63, wave = tid >> 6, r = lane & 31, h = lane >> 5, wa = wave >> 1, wb = wave & 1;
  const int ntile = t & 1, mt = (t >> 1) & 1, b = t >> 2;
  const u16* A3 = (const u16*)(p.ws + OFF_A3T) + (size_t)mt * 128 * 512;
  const u16* Z = (const u16*)(p.ws + OFF_Z);
  u16* CAT = (u16*)(p.ws + OFF_CAT);
  f32x16 acc[2][2]; float rinv[2];
  gemm128<1, false>(A3, 512, [&](int k) { return Z + (size_t)(NLAT + b * 256 + (k & 255)) * ZW + (k >> 8) * 256 + ntile * 128; }, 512, lds, acc, rinv);
#pragma unroll
  for (int i = 0; i < 2; ++i) {
    const int kk = mt * 128 + wa * 64 + i * 32 + r;
    u16* crow_ = CAT + (size_t)(NLAT + b * 256 + kk) * DM;
#pragma unroll
    for (int j = 0; j < 2; ++j)
#pragma unroll
      for (int g = 0; g < 4; ++g) {
        const int ch = ntile * 128 + wb * 64 + j * 32 + 8 * g + 4 * h;
        *(u32x2*)(crow_ + ch) = pack4(acc[i][j][4 * g] * (1.f / 128.f), acc[i][j][4 * g + 1] * (1.f / 128.f), acc[i][j][4 * g + 2] * (1.f / 128.f), acc[i][j][4 * g + 3] * (1.f / 128.f));
      }
  }
}
constexpr int N_UP256 = (NT / 256) * 7, N_CONV = NT / 32, N_FFT1 = 2 * 128 * 4, N_CDFT = 8;
DI void phase_mid(const Params& p, int l, char* lds, LAS char* lds3) {
  for (int it = blockIdx.x; it < N_UP256; it += gridDim.x) mid_up256(p, l, it, (it + (int)gridDim.x < N_UP256) ? it + (int)gridDim.x : -1, lds3);
  __syncthreads();
  for (int it = vbid(); it < N_CONV + N_FFT1 + N_CDFT; it += vgrid()) {
    int t = it;
    if (t < N_CDFT) { mid_ctxdft(p, t, lds); continue; }
    t -= N_CDFT;
    if (t < N_FFT1) { mid_fft1(p, t, lds); continue; }
    t -= N_FFT1;
    mid_conv(p, l, t, lds);
  }
}

DI void attn_fft2(const Params& p, int t, char* lds) {
  const int tid = ltid() & 255, lane = tid & 63, wave = tid >> 6, r = lane & 31, h = lane >> 5, wa = wave >> 1, wb = wave & 1;
  const int ntile = t & 1, k1 = (t >> 1) & 127, b = t >> 8;
  const u16* A2 = (const u16*)(p.ws + OFF_A2T);
  const u16* Y = (const u16*)(p.ws + OFF_Y);
  u16* CAT = (u16*)(p.ws + OFF_CAT);
  f32x16 acc[2][2]; float rinv[2];
  gemm128<1, false>(A2, 256, [&](int k) { return Y + ((size_t)(b * 128 + k1) * 128 + (k & 127)) * 512 + (k >> 7) * 256 + ntile * 128; }, 256, lds, acc, rinv);
#pragma unroll
  for (int i = 0; i < 2; ++i) {
    const int k2 = wa * 64 + i * 32 + r;
    u16* crow_ = CAT + (size_t)(b * SEQ + k1 + 128 * k2) * DM;
#pragma unroll
    for (int j = 0; j < 2; ++j)
#pragma unroll
      for (int g = 0; g < 4; ++g) {
        const int ch = ntile * 128 + wb * 64 + j * 32 + 8 * g + 4 * h;
        *(u32x2*)(crow_ + ch) = pack4(acc[i][j][4 * g] * (1.f / 1024.f), acc[i][j][4 * g + 1] * (1.f / 1024.f), acc[i][j][4 * g + 2] * (1.f / 1024.f), acc[i][j][4 * g + 3] * (1.f / 1024.f));
      }
  }
}
constexpr int AST = 40960;
DI void attn8(const u16* __restrict__ Qp, const u16* __restrict__ Kp, const u16* __restrict__ Vp, int nkeys, u16* __restrict__ Op, LAS char* lds) {
  const int tid = ltid(), wid = __builtin_amdgcn_readfirstlane(tid >> 6), lane = tid & 63, r = lane & 31, h = lane >> 5;
  bf16x8 qf[6];
  {
    const u16* qrow = Qp + (size_t)(wid * 32 + r) * 768 + 8 * h;
#pragma unroll
    for (int s = 0; s < 6; ++s) qf[s] = *(const bf16x8*)(qrow + 16 * s);
  }
  const char* src[5];
#pragma unroll
  for (int i = 0; i < 5; ++i) {
    const int pce = wid * 5 + i;
    if (pce < 24) {
      const int byte = pce * 1024 + lane * 16, row = byte / 192, sl = (byte % 192) >> 4;
      src[i] = (const char*)Kp + row * 192 + ((sl ^ ((row >> 2) & 3)) << 4);
    } else {
      const int hv = (pce - 24) >> 3, byte = ((pce - 24) & 7) * 1024 + lane * 16, d = byte >> 7, sl = (byte & 127) >> 4;
      src[i] = (const char*)Vp + (size_t)d * (NKEYS * 2) + hv * 128 + ((sl ^ ((d >> 1) & 7)) << 4);
    }
  }
  auto issue = [&](int slot) {
#pragma unroll
    for (int i = 0; i < 5; ++i) {
      const int pce = wid * 5 + i;
      __builtin_amdgcn_global_load_lds((const unsigned*)src[i], (LAS unsigned*)(lds + slot * AST + pce * 1024), 16, 0, 0);
      src[i] += (pce < 24) ? 128 * 192 : 256;
    }
  };
  const int x2 = (r >> 2) & 3, y3 = (r >> 1) & 7;
  const int ko_e = r * 192 + ((h ^ x2) << 4), ko_o = r * 192 + (((2 + h) ^ x2) << 4);
  int vo[4];
#pragma unroll
  for (int sl = 0; sl < 4; ++sl) vo[sl] = r * 128 + (((2 * sl + h) ^ y3) << 4);
  f32x16 o0, o1;
#pragma unroll
  for (int q = 0; q < 16; ++q) { o0[q] = 0.f; o1[q] = 0.f; }
  float m_run = 0.f, l_run = 0.f;
  f32x16 negm;
#pragma unroll
  for (int q = 0; q < 16; ++q) negm[q] = 0.f;
  const int NST = nkeys / 128;
  asm volatile("s_waitcnt vmcnt(0) lgkmcnt(0)" ::: "memory");
  __builtin_amdgcn_s_barrier();
  issue(0);
  if (NST > 1) issue(1);
  int slot = 0;
  for (int t = 0; t < NST; ++t) {
    if (t + 1 < NST) asm volatile("s_waitcnt vmcnt(5)" ::: "memory"); else asm volatile("s_waitcnt vmcnt(0)" ::: "memory");
    __builtin_amdgcn_s_barrier();
    __builtin_amdgcn_sched_barrier(0);
    if (t + 2 < NST) { int s2 = slot + 2; if (s2 >= 3) s2 -= 3; issue(s2); }
    __builtin_amdgcn_sched_barrier(0);
    LAS const char* Sb = lds + slot * AST;
#pragma unroll
    for (int hv = 0; hv < 2; ++hv) {
      f32x16 s0, s1;
      bf16x8 ka0[6], ka1[6];
#pragma unroll
      for (int s = 0; s < 6; ++s) {
        const int ko = (s & 1) ? ko_o : ko_e;
        ka0[s] = *(const LAS bf16x8*)(Sb + (hv * 64) * 192 + (s >> 1) * 64 + ko);
        ka1[s] = *(const LAS bf16x8*)(Sb + (hv * 64 + 32) * 192 + (s >> 1) * 64 + ko);
      }
      __builtin_amdgcn_sched_barrier(0);
      s0 = MFMA(ka0[0], qf[0], negm); s1 = MFMA(ka1[0], qf[0], negm);
#pragma unroll
      for (int s = 1; s < 6; ++s) { s0 = MFMA(ka0[s], qf[s], s0); s1 = MFMA(ka1[s], qf[s], s1); }
      LAS const char* Vb = Sb + 24576 + hv * 8192;
      bf16x8 vf0[4], vf1[4];
#pragma unroll
      for (int sl = 0; sl < 4; ++sl) { vf0[sl] = *(const LAS bf16x8*)(Vb + vo[sl]); vf1[sl] = *(const LAS bf16x8*)(Vb + 32 * 128 + vo[sl]); }
      __builtin_amdgcn_sched_barrier(0);
      float mt_ = s0[0];
#pragma unroll
      for (int q = 1; q < 16; ++q) mt_ = fmaxf(mt_, s0[q]);
#pragma unroll
      for (int q = 0; q < 16; ++q) mt_ = fmaxf(mt_, s1[q]);
      mt_ = swap_max(mt_);
      const bool first = (hv == 0) && (t == 0);
      if (first || !__all(mt_ <= 8.f)) {
        const float delta = first ? mt_ : fmaxf(mt_, 0.f);
        const float alpha = first ? 1.f : __builtin_amdgcn_exp2f(-delta);
        m_run += delta;
        l_run *= alpha;
#pragma unroll
        for (int q = 0; q < 16; ++q) { o0[q] *= alpha; o1[q] *= alpha; s0[q] -= delta; s1[q] -= delta; negm[q] = -m_run; }
      }
      float ps = 0.f;
#pragma unroll
      for (int q = 0; q < 16; ++q) { s0[q] = __builtin_amdgcn_exp2f(s0[q]); ps += s0[q]; }
#pragma unroll
      for (int q = 0; q < 16; ++q) { s1[q] = __builtin_amdgcn_exp2f(s1[q]); ps += s1[q]; }
      l_run += ps;
      bf16x8 pf[4];
      {
        u32x4 w;
        w[0] = cvtpk(s0[0], s0[1]); w[1] = cvtpk(s0[2], s0[3]); w[2] = cvtpk(s0[4], s0[5]); w[3] = cvtpk(s0[6], s0[7]); pf[0] = __builtin_bit_cast(bf16x8, w);
        w[0] = cvtpk(s0[8], s0[9]); w[1] = cvtpk(s0[10], s0[11]); w[2] = cvtpk(s0[12], s0[13]); w[3] = cvtpk(s0[14], s0[15]); pf[1] = __builtin_bit_cast(bf16x8, w);
        w[0] = cvtpk(s1[0], s1[1]); w[1] = cvtpk(s1[2], s1[3]); w[2] = cvtpk(s1[4], s1[5]); w[3] = cvtpk(s1[6], s1[7]); pf[2] = __builtin_bit_cast(bf16x8, w);
        w[0] = cvtpk(s1[8], s1[9]); w[1] = cvtpk(s1[10], s1[11]); w[2] = cvtpk(s1[12], s1[13]); w[3] = cvtpk(s1[14], s1[15]); pf[3] = __builtin_bit_cast(bf16x8, w);
      }
#pragma unroll
      for (int sl = 0; sl < 4; ++sl) { o0 = MFMA(vf0[sl], pf[sl], o0); o1 = MFMA(vf1[sl], pf[sl], o1); }
    }
    slot = (slot == 2) ? 0 : slot + 1;
  }
  const float linv = 1.f / swap_sum(l_run);
  u16* orow = Op + (size_t)(wid * 32 + r) * DM;
#pragma unroll
  for (int g = 0; g < 4; ++g) {
    *(u32x2*)(orow + 8 * g + 4 * h) = pack4(o0[4 * g] * linv, o0[4 * g + 1] * linv, o0[4 * g + 2] * linv, o0[4 * g + 3] * linv);
    *(u32x2*)(orow + 32 + 8 * g + 4 * h) = pack4(o1[4 * g] * linv, o1[4 * g + 1] * linv, o1[4 * g + 2] * linv, o1[4 * g + 3] * linv);
  }
}
constexpr int N_FFT2 = 2 * 128 * 2, N_ACTX = 2 * NH, N_ALAT = 2 * NH * 64;
DI void phase_attn(const Params& p, char* lds, LAS char* lds3) {
  const u16* Q = (const u16*)(p.ws + OFF_Q); const u16* Kb = (const u16*)(p.ws + OFF_K); const u16* Vt = (const u16*)(p.ws + OFF_VT);
  u16* CAT = (u16*)(p.ws + OFF_CAT);
  for (int it = vbid(); it < N_FFT2; it += vgrid()) attn_fft2(p, it, lds);
  __syncthreads();
  for (int it = blockIdx.x; it < N_ACTX + N_ALAT; it += gridDim.x) {
    int t = it;
    if (t < N_ACTX) {
      const int hh = t & 7, b = t >> 3;
      const int row0 = NLAT + b * 256;
      attn8(Q + (size_t)row0 * 768 + hh * 96, Kb + (size_t)(b * NH + hh) * NKEYS * 96, Vt + (size_t)(b * NH + hh) * 64 * NKEYS, CTXL,
            CAT + (size_t)row0 * DM + 256 + hh * 64, lds3);
      continue;
    }
    t -= N_ACTX;
    {
      const int qt = t & 63, hh = (t >> 6) & 7, b = t >> 9;
      const int row0 = b * SEQ + qt * 256;
      attn8(Q + (size_t)row0 * 768 + hh * 96, Kb + (size_t)(b * NH + hh) * NKEYS * 96, Vt + (size_t)(b * NH + hh) * 64 * NKEYS, NKEYS,
            CAT + (size_t)row0 * DM + 256 + hh * 64, lds3);
    }
  }
}

template <int KFULL, int KS>
DI void resid_gemm_phase(const Params& p, int l, const u16* __restrict__ W, const u16* __restrict__ X, int gate_chunk, LAS char* lds) {
  constexpr int NWHOLE = (NLAT / 256) * 4, KC = KFULL / KS;
  const int nitems = NWHOLE + ((l == NLAYER - 1) ? 0 : 8 * KS);
  float* slab = (float*)(p.ws + OFF_SLAB);
  for (int t = blockIdx.x; t < nitems; t += gridDim.x) {
    f32x4 acc[2][2][4][2];
    const bool split = t >= NWHOLE;
    auto tile_of = [&](int ti, int& tile_, int& kc_) {
      const int u_ = ti - NWHOLE, bx = ti & 7, bs = (ti & 255) >> 3, rnd = ti >> 8;
      tile_ = ti >= NWHOLE ? NWHOLE + u_ / KS : (rnd * 64 + bx * 8 + (bs >> 2)) * 4 + (bs & 3); kc_ = ti >= NWHOLE ? u_ % KS : 0; };
    int tile, kc; tile_of(t, tile, kc);
    const int tt = tile / 4, ft = tile % 4;
    const int tn = t + gridDim.x; const bool hn = tn < nitems;
    int tile_n = 0, kc_n = 0; if (hn) tile_of(tn, tile_n, kc_n);
    gemm256(W + (size_t)ft * 256 * KFULL + kc * KC, KFULL, X + (size_t)tt * 256 * KFULL + kc * KC, KFULL, split ? KC / 64 : KFULL / 64, lds, acc, t != (int)blockIdx.x,
            hn ? W + (size_t)(tile_n % 4) * 256 * KFULL + kc_n * KC : nullptr, hn ? X + (size_t)(tile_n / 4) * 256 * KFULL + kc_n * KC : nullptr);
    G_LANE_IDS
    if (split) {
      float* sb = slab + (size_t)kc * NCTX * DM;
      G_FOREACH(acc, {
        const int F = ft * 256 + f0, T = tt * 256 + tok - NLAT;
        *(float4*)(sb + (size_t)T * DM + F) = make_float4(v[0], v[1], v[2], v[3]);
      });
    } else {
      const float* gate = modp(p, l, mod_index(tt * 256), gate_chunk);
      G_FOREACH(acc, {
        const int F = ft * 256 + f0, T = tt * 256 + tok;
        float* xr = xrow(p, T) + F;
        const float4 gt = *(const float4*)(gate + F);
        float4 xv = *(float4*)xr;
        xv.x += gt.x * v[0]; xv.y += gt.y * v[1]; xv.z += gt.z * v[2]; xv.w += gt.w * v[3];
        *(float4*)xr = xv;
      });
    }
  }
}
constexpr int KS_WO = 4, KS_M2 = 8;
DI void phase_wo(const Params& p, int l, LAS char* lds) {
  resid_gemm_phase<DM, KS_WO>(p, l, (const u16*)(p.ws + OFF_WO) + (size_t)l * DM * DM, (const u16*)(p.ws + OFF_CAT), 2, lds);
}
DI void phase_mlp1(const Params& p, int l, LAS char* lds) {
  const u16* W1 = (const u16*)(p.ws + OFF_W1) + (size_t)l * DFF * DM;
  const u16* H = (const u16*)(p.ws + OFF_H);
  u16* A1 = (u16*)(p.ws + OFF_A1);
  const int ntt = (l == NLAYER - 1) ? NLAT / 256 : NT / 256;
  for (int t = blockIdx.x; t < ntt * 16; t += gridDim.x) {
    const int tt = t / 16, ft = t % 16;
    const int tn = t + gridDim.x; const bool hn = tn < ntt * 16;
    f32x4 acc[2][2][4][2];
    gemm256(W1 + (size_t)ft * 256 * DM, DM, H + (size_t)tt * 256 * DM, DM, DM / 64, lds, acc, t != (int)blockIdx.x,
            hn ? W1 + (size_t)(tn % 16) * 256 * DM : nullptr, hn ? H + (size_t)(tn / 16) * 256 * DM : nullptr);
    G_LANE_IDS
    G_FOREACH(acc, {
      const int F = ft * 256 + f0, T = tt * 256 + tok;
      const float a = fmaxf(v[0], 0.f), b = fmaxf(v[1], 0.f), c = fmaxf(v[2], 0.f), d = fmaxf(v[3], 0.f);
      *(u32x2*)(A1 + (size_t)T * DFF + F) = pack4(a * a, b * b, c * c, d * d);
    });
  }
}
DI void phase_mlp2(const Params& p, int l, LAS char* lds) {
  resid_gemm_phase<DFF, KS_M2>(p, l, (const u16*)(p.ws + OFF_W2) + (size_t)l * DM * DFF, (const u16*)(p.ws + OFF_A1), 5, lds);
}
DI void phase_final(const Params& p) {
  const int tid = ltid(), lane = tid & 63, wave = tid >> 6;
  const int RS = gridDim.x * 8;
  float4 g4[4];
#pragma unroll
  for (int i = 0; i < 4; ++i) g4[i] = *(const float4*)(p.final_norm_g + i * 256 + lane * 4);
  for (int row0 = blockIdx.x * 8 + wave; row0 < NLAT; row0 += RS * 4) {
    float4 v[4][4]; float ss[4];
#pragma unroll
    for (int k = 0; k < 4; ++k) {
      const int row = row0 + k * RS;
      const float* xr = p.out + (size_t)(row < NLAT ? row : row0) * DM;
#pragma unroll
      for (int i = 0; i < 4; ++i) v[k][i] = *(const float4*)(xr + i * 256 + lane * 4);
    }
#pragma unroll
    for (int k = 0; k < 4; ++k) {
      float a = 0.f;
#pragma unroll
      for (int i = 0; i < 4; ++i) a += v[k][i].x * v[k][i].x + v[k][i].y * v[k][i].y + v[k][i].z * v[k][i].z + v[k][i].w * v[k][i].w;
      ss[k] = wave_sum(a);
    }
#pragma unroll
    for (int k = 0; k < 4; ++k) {
      const int row = row0 + k * RS;
      if (row < NLAT) {
        const float rinv = rsqrtf(ss[k] * (1.f / DM) + EPS);
        float* xr = p.out + (size_t)row * DM;
#pragma unroll
        for (int i = 0; i < 4; ++i)
          *(float4*)(xr + i * 256 + lane * 4) = make_float4(v[k][i].x * rinv * g4[i].x, v[k][i].y * rinv * g4[i].y, v[k][i].z * rinv * g4[i].z, v[k][i].w * rinv * g4[i].w);
      }
    }
  }
}

constexpr int N_PHASES = 2 + 8 * NLAYER;
DI void run_phase(const Params& p, int ph, char* lds_all) {
#define HLDS (lds_all + (ltid() >> 8) * 73728)
  LAS char* lds3 = (LAS char*)lds_all;
  if (ph == 0) { phase_prep(p, HLDS); return; }
  if (ph == N_PHASES - 1) { phase_final(p); return; }
  const int l = (ph - 1) >> 3, s = (ph - 1) & 7;
  switch (s) {
    case 0: phase_norm(p, l, 0, lds_all); break;
    case 1: phase_win(p, l, lds3); break;
    case 2: phase_mid(p, l, HLDS, lds3); break;
    case 3: phase_attn(p, HLDS, lds3); break;
    case 4: phase_wo(p, l, lds3); break;
    case 5: phase_norm(p, l, 1, lds_all); break;
    case 6: phase_mlp1(p, l, lds3); break;
    default: phase_mlp2(p, l, lds3); break;
  }
}

extern __shared__ __attribute__((aligned(16))) char dyn_lds[];

#ifndef DIAG
#define DIAG 0
#endif
#ifndef DIAG_A
#define DIAG_A 0x008
#endif
#ifndef DIAG_B
#define DIAG_B 0x0C0
#endif
__global__ void __launch_bounds__(512, 2) mega_kernel(Params p) {
  cg::grid_group grid = cg::this_grid();
  volatile LAS unsigned* st = (volatile LAS unsigned*)((LAS char*)dyn_lds + LDS_PHASE);
  if (threadIdx.x == 0) { st[0] = 0u; st[1] = 0u; st[2] = 0u; st[3] = 0u; }
  __syncthreads();
  (void)xcd_barrier_post((unsigned*)(p.ws + OFF_BAR), st);
#define MK_XB() XcdBarrier{(unsigned*)(p.ws + OFF_BAR), xb_xcc_id(), (volatile LAS unsigned*)((LAS char*)dyn_lds + LDS_PHASE)}
#if DIAG
  unsigned long long* TS = (unsigned long long*)(p.ws + OFF_TS);
  const bool rec = (blockIdx.x == 0 && threadIdx.x == 0);
  if (rec) TS[0] = wall_clock64();
#endif
  for (int ph = 0; ph < N_PHASES; ++ph) {
    run_phase(p, ph, dyn_lds);
#if DIAG
    if (ph == 0) grid.sync(); else xcd_barrier(MK_XB());
    if (rec) TS[ph + 1] = wall_clock64();
#else
    if (ph == 0) grid.sync(); else if (ph + 1 < N_PHASES) xcd_barrier(MK_XB());
#endif
  }
#if DIAG
  if (blockIdx.x == 0) {
    unsigned long long ta = 0, tb = 0;
    for (int ph = 0; ph < N_PHASES; ++ph) {
      const int type = ph == 0 ? 8 : (ph == N_PHASES - 1 ? 9 : ((ph - 1) & 7));
      const unsigned long long d = TS[ph + 1] - TS[ph];
      if ((DIAG_A >> type) & 1) ta += d;
      if ((DIAG_B >> type) & 1) tb += d;
    }
    const float vb = (float)tb * 0.01f * 0.00002f;
    (void)ta;
    for (int i = threadIdx.x; i < 4096; i += 512) p.out[i] += (i == 0) ? 0.f : vb;
  }
#endif
}
#if MK_MULTI
__global__ void __launch_bounds__(512, 2) phase_kernel(Params p, int ph) { run_phase(p, ph, dyn_lds); }
#endif

extern "C" void kernel_launch(void* const* d_in, const int* in_sizes, int n_in, void* d_out, int out_size, void* d_ws, size_t ws_size,
                              hipStream_t stream) {
  Params p{};
  const float** f = (const float**)&p;
  for (int i = 0; i < 23; ++i) f[i] = (const float*)d_in[i];
  p.out = (float*)d_out;
  p.ws = (char*)d_ws;
  if (ws_size < WS_TOTAL) { fprintf(stderr, "kernel_launch: ws too small: %zu < %zu\n", ws_size, (size_t)WS_NEED); return; }
  static int grid_blocks = 0;
  if (!grid_blocks) {
    (void)hipFuncSetAttribute((const void*)mega_kernel, hipFuncAttributeMaxDynamicSharedMemorySize, LDS_BYTES);
#if MK_MULTI
    (void)hipFuncSetAttribute((const void*)phase_kernel, hipFuncAttributeMaxDynamicSharedMemorySize, LDS_BYTES);
#endif
    int dev = 0, cus = 0, per_cu = 0;
    (void)hipGetDevice(&dev);
    (void)hipDeviceGetAttribute(&cus, hipDeviceAttributeMultiprocessorCount, dev);
    (void)hipOccupancyMaxActiveBlocksPerMultiprocessor(&per_cu, mega_kernel, 512, LDS_BYTES);
    if (per_cu > 1) per_cu = 1;
    if (per_cu < 1) per_cu = 1;
    grid_blocks = cus * per_cu;
  }
#if MK_MULTI
  for (int ph = 0; ph < N_PHASES; ++ph) hipLaunchKernelGGL(phase_kernel, dim3(grid_blocks), dim3(512), LDS_BYTES, stream, p, ph);
#else
  (void)hipMemsetAsync((char*)d_ws + OFF_BAR, 0, XCD_BAR_WORDS * 4, stream);
  void* args[] = {&p};
  hipError_t e = hipLaunchCooperativeKernel((void*)mega_kernel, dim3(grid_blocks), dim3(512), args, LDS_BYTES, stream);
  if (e != hipSuccess) fprintf(stderr, "cooperative launch failed: %s (grid %d)\n", hipGetErrorString(e), grid_blocks);
#endif
}
```

```cpp
#include <hip/hip_runtime.h>
#include <hip/hip_cooperative_groups.h>
#include <cstdio>
#include <cstdint>
namespace cg = cooperative_groups;

#ifndef MK_MULTI
#define MK_MULTI 0
#endif

typedef unsigned short u16;
using bf16x8 = __attribute__((ext_vector_type(8))) short;
using f32x16 = __attribute__((ext_vector_type(16))) float;
using u32x4  = __attribute__((ext_vector_type(4))) unsigned;
using u32x2  = __attribute__((ext_vector_type(2))) unsigned;
#define DI __device__ __forceinline__
#define MFMA(a, b, c) __builtin_amdgcn_mfma_f32_32x32x16_bf16((a), (b), (c), 0, 0, 0)

constexpr int DM = 1024, NLAT = 32768, NCTX = 512, NT = NLAT + NCTX, SEQ = 16384, CTXL = 256, NLAYER = 4;
constexpr int ZW = 1440, NINP = 1536, DFF = 4096, NKEYS = SEQ + CTXL, NH = 8;
constexpr int MT = NT / 128;
constexpr float EPS = 1e-6f;
constexpr float QSCALE = 0.10206207261596575f * 1.4426950408889634f;

constexpr size_t al256(size_t x) { return (x + 255) / 256 * 256; }
constexpr size_t SZ_WIN = (size_t)NLAYER * NINP * DM * 2, SZ_WUQ = (size_t)NLAYER * 768 * 256 * 2, SZ_WUKV = (size_t)NLAYER * 1024 * 256 * 2;
constexpr size_t SZ_WO = (size_t)NLAYER * DM * DM * 2, SZ_W1 = (size_t)NLAYER * DFF * DM * 2, SZ_W2 = SZ_W1;
constexpr size_t OFF_WIN = 0, OFF_WUQ = OFF_WIN + SZ_WIN, OFF_WUKV = OFF_WUQ + SZ_WUQ, OFF_WO = OFF_WUKV + SZ_WUKV;
constexpr size_t OFF_W1 = OFF_WO + SZ_WO, OFF_W2 = OFF_W1 + SZ_W1, OFF_MOD = OFF_W2 + SZ_W2;
constexpr size_t OFF_A1T = OFF_MOD + al256((size_t)NLAYER * 3 * 6144 * 4);
constexpr size_t OFF_A2T = OFF_A1T + 256 * 256 * 2, OFF_A3T = OFF_A2T + 128 * 256 * 2, OFF_TW = OFF_A3T + 256 * 512 * 2;
constexpr size_t OFF_ROPE = OFF_TW + 16384 * 8, OFF_XRC = OFF_ROPE + 256 * 8 * 8, OFF_H = OFF_XRC + (size_t)NCTX * DM * 4;
constexpr size_t OFF_UNI = OFF_H + (size_t)NT * DM * 2;
constexpr size_t OFF_Z = OFF_UNI, OFF_Q = OFF_Z + (size_t)NT * ZW * 2, OFF_K = OFF_Q + (size_t)NT * 768 * 2;
constexpr size_t OFF_VT = OFF_K + (size_t)2 * NH * NKEYS * 96 * 2, OFF_CAT = OFF_VT + (size_t)2 * NH * 64 * NKEYS * 2;
constexpr size_t OFF_Y = OFF_CAT + (size_t)NT * DM * 2, UNI_END = OFF_Y + (size_t)2 * SEQ * 512 * 2;
constexpr size_t OFF_A1 = OFF_UNI, A1_END = OFF_A1 + (size_t)NT * DFF * 2;
constexpr size_t WS_NEED = UNI_END > A1_END ? UNI_END : A1_END;
constexpr int LDS_PHASE = 2 * 73728;
constexpr int LDS_BYTES = LDS_PHASE + 16;
constexpr size_t OFF_TS = al256(WS_NEED), OFF_BAR = OFF_TS + 4096, OFF_SLAB = al256(OFF_BAR + 3456 * 4), OFF_SSQ = OFF_SLAB + (size_t)8 * NCTX * DM * 4, WS_TOTAL = OFF_SSQ + (size_t)NT * 2 * 4;

struct Params {
  const float *x, *c, *ctx, *c_ctx, *w_mod, *b_mod, *norm1_g, *w_in, *q_norm_g, *w_uq, *kv_norm_g, *w_ukv, *w_fourier, *w_dw, *b_dw,
      *conv_ln_g, *conv_ln_b, *w_pw2, *w_o, *norm2_g, *w_mlp1, *w_mlp2, *final_norm_g;
  float* out;
  char* ws;
};

DI int ltid() { int t = threadIdx.x; asm volatile("" : "+v"(t)); return t; }
DI int vbid() { int h = __builtin_amdgcn_readfirstlane((int)(threadIdx.x >> 8)); asm volatile("" : "+s"(h)); return blockIdx.x * 2 + h; }
DI int vgrid() { return gridDim.x * 2; }
#define LAS __attribute__((address_space(3)))
using f32x4 = __attribute__((ext_vector_type(4))) float;
DI int crow(int reg, int h) { return (reg & 3) + 8 * (reg >> 2) + 4 * h; }
DI unsigned cvtpk(float lo, float hi) { unsigned r; asm("v_cvt_pk_bf16_f32 %0, %1, %2" : "=v"(r) : "v"(lo), "v"(hi)); return r; }
DI u16 f2bf(float x) { return (u16)(cvtpk(x, 0.f) & 0xffffu); }
DI float bf2f(u16 v) { return __uint_as_float(((unsigned)v) << 16); }
DI u32x2 pack4(float a, float b, float c, float d) { u32x2 r; r[0] = cvtpk(a, b); r[1] = cvtpk(c, d); return r; }
DI float shx(float v, int o) { const int ln = ltid() & 63; return __builtin_bit_cast(float, __builtin_amdgcn_ds_bpermute((ln ^ o) << 2, __builtin_bit_cast(int, v))); }
DI float wave_sum(float v) {
#pragma unroll
  for (int o = 32; o; o >>= 1) v += shx(v, o);
  return v;
}
DI float swap_max(float v) {
  auto rr = __builtin_amdgcn_permlane32_swap(__float_as_uint(v), __float_as_uint(v), false, false);
  return fmaxf(__uint_as_float(rr[0]), __uint_as_float(rr[1]));
}
DI float swap_sum(float v) {
  auto rr = __builtin_amdgcn_permlane32_swap(__float_as_uint(v), __float_as_uint(v), false, false);
  return __uint_as_float(rr[0]) + __uint_as_float(rr[1]);
}
DI float sigmoidf_(float x) { return 1.f / (1.f + __expf(-x)); }
DI float* xrow(const Params& p, int row) { return row < NLAT ? p.out + (size_t)row * DM : (float*)(p.ws + OFF_XRC) + (size_t)(row - NLAT) * DM; }
DI int mod_index(int row) { return row < NLAT ? (row >> 14) : 2; }
DI const float* modp(const Params& p, int l, int mi, int chunk) { return (const float*)(p.ws + OFF_MOD) + ((size_t)(l * 3 + mi) * 6 + chunk) * 1024; }
DI void tok_info(int m, int& b, int& key, bool& lat, int& pos) {
  if (m < NLAT) { b = m >> 14; pos = m & (SEQ - 1); key = CTXL + pos; lat = true; }
  else { int mm = m - NLAT; b = mm >> 8; pos = mm & 255; key = pos; lat = false; }
}
DI int vpos(int key) { return (key & ~12) | ((key & 4) << 1) | ((key & 8) >> 1); }


#define XB_TMO      128
#define XB_XCNT(j)  (256  + 64 * (j))
#define XB_XSUB(j)  (1280 + 64 * (j))
#define XB_XGEN(j)  (2304 + 64 * (j))
#define XB_TOP      3328
#define XB_TOPGEN   3392
#define XCD_BAR_WORDS 3456
#define XB_SPIN_CAP (1u << 22)
DI unsigned xb_ld(unsigned* p) { return __hip_atomic_load(p, __ATOMIC_RELAXED, __HIP_MEMORY_SCOPE_AGENT); }
DI unsigned xb_add(unsigned* p, unsigned v) { return __hip_atomic_fetch_add(p, v, __ATOMIC_RELAXED, __HIP_MEMORY_SCOPE_AGENT); }
DI unsigned xb_xcc_id() { return (unsigned)__builtin_amdgcn_s_getreg((3 << 11) | 20) & 0xFu; }
#define XB_SPIN(cond, bar) do { unsigned _sp = 0; while (cond) { __builtin_amdgcn_s_sleep(1); \
    if ((++_sp & 255u) == 0u) { if (xb_ld(&(bar)[XB_TMO])) break; if (_sp > XB_SPIN_CAP) { atomicAdd(&(bar)[XB_TMO], 1u); break; } } } } while (0)
struct XcdBarrier { unsigned* bar; unsigned x; volatile LAS unsigned* st; };
DI XcdBarrier xcd_barrier_post(unsigned* bar, volatile LAS unsigned* st) {
  XcdBarrier b; b.bar = bar; b.x = xb_xcc_id(); b.st = st;
  if (threadIdx.x == 0) (void)xb_add(&bar[XB_XCNT(b.x)], 1u);
  return b;
}
DI void xcd_barrier_complete(unsigned* bar, unsigned x, unsigned& nloc, unsigned& nx) {
  const unsigned G = gridDim.x * gridDim.y * gridDim.z;
  unsigned sum, cnt, mine, sp = 0u;
  for (;;) {
    sum = 0u; cnt = 0u; mine = 0u;
#pragma unroll
    for (unsigned j = 0; j < 16; ++j) { const unsigned c = xb_ld(&bar[XB_XCNT(j)]); sum += c; cnt += (c > 0u) ? 1u : 0u; mine = (j == x) ? c : mine; }
    if (sum == G) break;
    __builtin_amdgcn_s_sleep(1);
    if ((++sp & 255u) == 0u) { if (xb_ld(&bar[XB_TMO])) break; if (sp > XB_SPIN_CAP) { atomicAdd(&bar[XB_TMO], 1u); break; } }
  }
  nloc = mine > 0u ? mine : 1u; nx = cnt > 0u ? cnt : 1u;
}
DI void xcd_barrier(const XcdBarrier& b) {
  asm volatile("s_waitcnt vmcnt(0)" ::: "memory");
  __syncthreads();
  if (threadIdx.x == 0) {
    unsigned* bar = b.bar;
    __builtin_amdgcn_s_waitcnt(0);
    unsigned nloc = b.st[0], nx = b.st[1];
    if (nloc == 0u) { xcd_barrier_complete(bar, b.x, nloc, nx); b.st[0] = nloc; b.st[1] = nx; }
    const unsigned old = xb_add(&bar[XB_XSUB(b.x)], 1u);
    const unsigned gen = old / nloc;
    if (old + 1u == (gen + 1u) * nloc) {
      __builtin_amdgcn_fence(__ATOMIC_RELEASE, "agent");
      asm volatile("s_waitcnt vmcnt(0)" ::: "memory");
      const unsigned og = xb_add(&bar[XB_TOP], 1u);
      const unsigned tg = og / nx;
      if (og + 1u == (tg + 1u) * nx) xb_add(&bar[XB_TOPGEN], 1u);
      else XB_SPIN(xb_ld(&bar[XB_TOPGEN]) == tg, bar);
      __builtin_amdgcn_fence(__ATOMIC_ACQUIRE, "agent");
      xb_add(&bar[XB_XGEN(b.x)], 1u);
      asm volatile("s_waitcnt vmcnt(0)" ::: "memory");
    } else {
      XB_SPIN(xb_ld(&bar[XB_XGEN(b.x)]) == gen, bar);
      __builtin_amdgcn_fence(__ATOMIC_ACQUIRE, "agent");
      asm volatile("s_waitcnt vmcnt(0)" ::: "memory");
    }
  }
  __syncthreads();
}

template <int BT, bool RMS, class BRow>
DI void gemm128(const u16* __restrict__ A, int lda, BRow brow, int K, char* lds_, f32x16 (&acc)[2][2], float (&rinv)[2]) {
  static_assert(BT == 1 && !RMS, "only the transposed-B form is used");
  const int tid = ltid() & 255, lane = tid & 63, wave = __builtin_amdgcn_readfirstlane(tid >> 6), r = lane & 31, h = lane >> 5;
  const int wa = wave >> 1, wb = wave & 1;
  LAS char* lds = (LAS char*)lds_;
#pragma unroll
  for (int i = 0; i < 2; ++i)
#pragma unroll
    for (int j = 0; j < 2; ++j)
#pragma unroll
      for (int q = 0; q < 16; ++q) acc[i][j][q] = 0.f;
  rinv[0] = rinv[1] = 1.f;
  const int KT = K / 64;
  unsigned aoff[4];
#pragma unroll
  for (int i = 0; i < 4; ++i) { const int row = (wave * 4 + i) * 8 + (lane >> 3), sl = lane & 7; aoff[i] = (unsigned)(row * lda + ((sl ^ ((row >> 1) & 7)) << 3)) * 2u; }
  auto issue = [&](int kt, int buf) {
#pragma unroll
    for (int i = 0; i < 4; ++i)
      __builtin_amdgcn_global_load_lds((const unsigned*)((const char*)A + aoff[i] + kt * 128), (LAS unsigned*)(lds + buf * 32768 + (wave * 4 + i) * 1024), 16, 0, 0);
#pragma unroll
    for (int i = 0; i < 4; ++i) {
      const int kr = (wave * 4 + i) * 4 + (lane >> 4);
      __builtin_amdgcn_global_load_lds((const unsigned*)(brow(kt * 64 + kr) + (lane & 15) * 8), (LAS unsigned*)(lds + buf * 32768 + 16384 + (wave * 4 + i) * 1024), 16, 0, 0);
    }
  };
  const int y3 = (r >> 1) & 7;
  asm volatile("s_waitcnt vmcnt(0) lgkmcnt(0)" ::: "memory");
  __builtin_amdgcn_s_barrier();
  issue(0, 0);
  for (int kt = 0; kt < KT; ++kt) {
    const int cur = kt & 1;
    asm volatile("s_waitcnt vmcnt(0)" ::: "memory");
    __builtin_amdgcn_s_barrier();
    __builtin_amdgcn_sched_barrier(0);
    if (kt + 1 < KT) issue(kt + 1, cur ^ 1);
    __builtin_amdgcn_sched_barrier(0);
    LAS const char* Ab = lds + cur * 32768 + (wa * 64 + r) * 128;
    LAS const u16* Bb = (LAS const u16*)(lds + cur * 32768 + 16384);
#pragma unroll
    for (int ks = 0; ks < 4; ++ks) {
      bf16x8 af[2], bfr[2];
#pragma unroll
      for (int i = 0; i < 2; ++i) af[i] = *(const LAS bf16x8*)(Ab + i * 32 * 128 + (((2 * ks + h) ^ y3) << 4));
#pragma unroll
      for (int j = 0; j < 2; ++j)
#pragma unroll
        for (int q = 0; q < 8; ++q) bfr[j][q] = (short)Bb[(ks * 16 + 8 * h + q) * 128 + wb * 64 + j * 32 + r];
#pragma unroll
      for (int i = 0; i < 2; ++i)
#pragma unroll
        for (int j = 0; j < 2; ++j) acc[i][j] = MFMA(af[i], bfr[j], acc[i][j]);
    }
  }
}

constexpr int HTB = 128 * 64 * 2;
DI int lds_byte(int r, int c) { int st = (r >> 4) * 2 + (c >> 5), rr = r & 15, cc = c & 31, ob = rr * 64 + cc * 2; return st * 1024 + (ob ^ (((ob >> 9) & 1) << 5)); }
DI void stage_rc(int b, int& R, int& C) { int st = b / 1024, sb = b % 1024, swz = sb ^ (((sb >> 9) & 1) << 5); R = (st >> 1) * 16 + swz / 64; C = (st & 1) * 32 + (swz % 64) / 2; }
DI void gemm256(const u16* __restrict__ A, int lda, const u16* __restrict__ Bt, int ldb, int nt, LAS char* lds, f32x4 (&acc)[2][2][4][2],
                bool pre = false, const u16* __restrict__ An = nullptr, const u16* __restrict__ Bn = nullptr) {
  const int tid = ltid(), wid = __builtin_amdgcn_readfirstlane(tid >> 6), lane = tid & 63, wr = wid >> 2, wc = wid & 3, fr = lane & 15, fq = lane >> 4;
  unsigned voffA[2], voffB[2];
#pragma unroll
  for (int i = 0; i < 2; ++i) { int R, C; stage_rc(tid * 16 + i * 8192, R, C); voffA[i] = (unsigned)(R * lda + C) * 2u; voffB[i] = (unsigned)(R * ldb + C) * 2u; }
  const size_t hstepA = (size_t)128 * lda * 2, hstepB = (size_t)128 * ldb * 2;
  const unsigned ldsw = (unsigned)wid * 1024u;
  const int aoff = lds_byte(wr * 64 + fr, fq * 8), boff = lds_byte(wc * 32 + fr, fq * 8);
  const char* Ab = (const char*)A; const char* Bb = (const char*)Bt;
#define G_SA(b, h) (((b) * 2 + (h)) * HTB)
#define G_SB(b, h) ((4 + (b) * 2 + (h)) * HTB)
#define G_AP(h, kt) (Ab + (size_t)(h) * hstepA + (size_t)(kt) * 128)
#define G_BP(h, kt) (Bb + (size_t)(h) * hstepB + (size_t)(kt) * 128)
#define G_STG(bufoff, gptr, voff_) do { _Pragma("unroll") for (int _i = 0; _i < 2; ++_i) \
    __builtin_amdgcn_global_load_lds((const unsigned*)((gptr) + voff_[_i]), (LAS unsigned*)(lds + (bufoff) + ldsw + _i * 8192), 16, 0, 0); } while (0)
#define G_LDA(dst, b, h) do { _Pragma("unroll") for (int m = 0; m < 4; ++m) _Pragma("unroll") for (int k = 0; k < 2; ++k) dst[m][k] = *(const LAS bf16x8*)(lds + G_SA(b, h) + aoff + m * 2048 + k * 1024); } while (0)
#define G_LDB(dst, b, h) do { _Pragma("unroll") for (int n = 0; n < 2; ++n) _Pragma("unroll") for (int k = 0; k < 2; ++k) dst[n][k] = *(const LAS bf16x8*)(lds + G_SB(b, h) + boff + n * 2048 + k * 1024); } while (0)
#define G_MMA(ai, bj, At_, Bt_) do { __builtin_amdgcn_s_setprio(1); _Pragma("unroll") for (int m = 0; m < 4; ++m) _Pragma("unroll") for (int n = 0; n < 2; ++n) _Pragma("unroll") for (int k = 0; k < 2; ++k) \
    acc[ai][bj][m][n] = __builtin_amdgcn_mfma_f32_16x16x32_bf16(At_[m][k], Bt_[n][k], acc[ai][bj][m][n], 0, 0, 0); __builtin_amdgcn_s_setprio(0); } while (0)
#define G_WV(n) asm volatile("s_waitcnt vmcnt(" #n ")" ::: "memory")
#define G_WL(n) asm volatile("s_waitcnt lgkmcnt(" #n ")" ::: "memory")
#define G_BAR __builtin_amdgcn_s_barrier()
#define G_SCHED __builtin_amdgcn_sched_barrier(0)
  float zer_ = 0.f; asm volatile("" : "+v"(zer_));
#pragma unroll
  for (int a = 0; a < 2; ++a)
#pragma unroll
    for (int b = 0; b < 2; ++b)
#pragma unroll
      for (int m = 0; m < 4; ++m)
#pragma unroll
        for (int n = 0; n < 2; ++n) acc[a][b][m][n] = (f32x4){zer_, zer_, zer_, zer_};
  bf16x8 At[4][2], B0[2][2], B1[2][2];
#define G_ISSUE7() do { G_STG(G_SB(0, 0), G_BP(0, 0), voffB); G_STG(G_SA(0, 0), G_AP(0, 0), voffA); G_STG(G_SB(0, 1), G_BP(1, 0), voffB); G_STG(G_SA(0, 1), G_AP(1, 0), voffA); \
    G_STG(G_SB(1, 0), G_BP(0, 1), voffB); G_STG(G_SA(1, 0), G_AP(0, 1), voffA); G_STG(G_SB(1, 1), G_BP(1, 1), voffB); } while (0)
  if (!pre) { G_WV(0); G_WL(0); G_BAR; G_ISSUE7(); }
  if (wr == 1) G_BAR;
  G_WV(10); G_BAR;
  G_WV(6); G_BAR;
  for (int t = 0; t < nt - 2; t += 2) {
    G_LDB(B0, 0, 0); G_SCHED; G_LDA(At, 0, 0); G_STG(G_SA(1, 1), G_AP(1, t + 1), voffA);
    G_WL(8); G_BAR; G_WL(0); G_MMA(0, 0, At, B0); G_BAR; G_SCHED;
    G_LDB(B1, 0, 1); G_STG(G_SB(0, 0), G_BP(0, t + 2), voffB);
    G_BAR; G_WL(0); G_MMA(0, 1, At, B1); G_BAR;
    G_LDA(At, 0, 1); G_STG(G_SA(0, 0), G_AP(0, t + 2), voffA);
    G_BAR; G_WL(0); G_MMA(1, 0, At, B0); G_BAR; G_SCHED;
    G_STG(G_SB(0, 1), G_BP(1, t + 2), voffB);
    G_WV(6); G_BAR; G_MMA(1, 1, At, B1); G_BAR;
    G_LDB(B0, 1, 0); G_SCHED; G_LDA(At, 1, 0); G_STG(G_SA(0, 1), G_AP(1, t + 2), voffA);
    G_WL(8); G_BAR; G_WL(0); G_MMA(0, 0, At, B0); G_BAR; G_SCHED;
    G_LDB(B1, 1, 1); G_STG(G_SB(1, 0), G_BP(0, t + 3), voffB);
    G_BAR; G_WL(0); G_MMA(0, 1, At, B1); G_BAR;
    G_LDA(At, 1, 1); G_STG(G_SA(1, 0), G_AP(0, t + 3), voffA);
    G_BAR; G_WL(0); G_MMA(1, 0, At, B0); G_BAR; G_SCHED;
    G_STG(G_SB(1, 1), G_BP(1, t + 3), voffB);
    G_WV(6); G_BAR; G_MMA(1, 1, At, B1); G_BAR;
  }
  { G_LDB(B0, 0, 0); G_LDA(At, 0, 0); G_STG(G_SA(1, 1), G_AP(1, nt - 1), voffA);
    G_BAR; G_WL(0); G_MMA(0, 0, At, B0); G_BAR;
    G_LDB(B1, 0, 1); G_BAR; G_WL(0); G_MMA(0, 1, At, B1); G_BAR;
    G_LDA(At, 0, 1); G_WV(4); G_BAR; G_WL(0); G_MMA(1, 0, At, B0); G_MMA(1, 1, At, B1); G_BAR; }
  { G_LDB(B0, 1, 0); G_LDA(At, 1, 0); G_WV(2); G_BAR; G_WL(0); G_MMA(0, 0, At, B0); G_BAR;
    G_LDB(B1, 1, 1); G_WV(0); G_BAR; G_WL(0); G_MMA(0, 1, At, B1); G_BAR;
    G_LDA(At, 1, 1); G_BAR; G_WL(0); G_MMA(1, 0, At, B0); G_MMA(1, 1, At, B1); G_BAR; }
  if (wr == 0) G_BAR;
  if (An != nullptr) { Ab = (const char*)An; Bb = (const char*)Bn; G_ISSUE7(); }
}
#define G_FOREACH(acc, ...) do { \
  _Pragma("unroll") for (int ai = 0; ai < 2; ++ai) _Pragma("unroll") for (int bj = 0; bj < 2; ++bj) \
  _Pragma("unroll") for (int m = 0; m < 4; ++m) _Pragma("unroll") for (int n = 0; n < 2; ++n) { \
    const int f0 = ai * 128 + wr * 64 + m * 16 + fq * 4, tok = bj * 128 + wc * 32 + n * 16 + fr; const f32x4 v = acc[ai][bj][m][n]; __VA_ARGS__ } } while (0)
#define G_LANE_IDS const int tid = ltid(), wid = tid >> 6, lane = tid & 63, wr = wid >> 2, wc = wid & 3, fr = lane & 15, fq = lane >> 4;

DI void rope_block(f32x16& v, int h, int pos, const float2* __restrict__ ropetab) {
  const int rowp = pos >> 6, colp = pos & 63;
#pragma unroll
  for (int g = 0; g < 2; ++g)
#pragma unroll
    for (int i = 0; i < 4; ++i) {
      const int f = 8 * g + 4 * h + i;
      const float2 cs = (f < 8) ? ropetab[rowp * 8 + f] : ropetab[colp * 8 + (f - 8)];
      const float x1 = v[4 * g + i], x2 = v[4 * (g + 2) + i];
      v[4 * g + i] = x1 * cs.x - x2 * cs.y;
      v[4 * (g + 2) + i] = x1 * cs.y + x2 * cs.x;
    }
}

DI void prep_transpose_tile(const float* __restrict__ W, int ldn, int k0, int n0, int nlimit, u16* __restrict__ Wt, int ldk, int ndst0, int kdst0,
                            const float* __restrict__ rowscale, char* lds) {
  float* t = (float*)lds;
  const int tid = ltid() & 255;
  __syncthreads();
#pragma unroll
  for (int it = 0; it < 16; ++it) {
    int i = (tid >> 6) + 4 * it, j = tid & 63;
    float v = 0.f;
    if (n0 + j < nlimit) v = W[(size_t)(k0 + i) * ldn + n0 + j];
    if (rowscale) v *= rowscale[k0 + i];
    t[i * 65 + j] = v;
  }
  __syncthreads();
#pragma unroll
  for (int it = 0; it < 16; ++it) {
    int j = (tid >> 6) + 4 * it, i = tid & 63;
    if (n0 + j < nlimit) Wt[(size_t)(ndst0 + j) * ldk + kdst0 + i] = f2bf(t[i * 65 + j]);
  }
}

DI void phase_prep(const Params& p, char* lds) {
  const int tid = ltid() & 255, G = vgrid(), bid = vbid();
  u16* Win = (u16*)(p.ws + OFF_WIN); u16* Wuq = (u16*)(p.ws + OFF_WUQ); u16* Wukv = (u16*)(p.ws + OFF_WUKV);
  u16* Wo = (u16*)(p.ws + OFF_WO); u16* W1 = (u16*)(p.ws + OFF_W1); u16* W2 = (u16*)(p.ws + OFF_W2);
  {
    const float4* xs = (const float4*)p.x; float4* xd = (float4*)p.out;
    for (size_t i = (size_t)bid * 256 + tid; i < (size_t)NLAT * DM / 4; i += (size_t)G * 256) xd[i] = xs[i];
    const float4* cs = (const float4*)p.ctx; float4* cd = (float4*)(p.ws + OFF_XRC);
    for (size_t i = (size_t)bid * 256 + tid; i < (size_t)NCTX * DM / 4; i += (size_t)G * 256) cd[i] = cs[i];
  }
  for (int e = bid * 256 + tid; e < NLAYER * 1024 * 16; e += G * 256) { const int row = e >> 4, c = e & 15; unsigned z_ = 0u; asm volatile("" : "+v"(z_)); *(uint4*)(Wukv + (size_t)row * 256 + 128 + c * 8) = make_uint4(z_, z_, z_, z_); }
  {
    u16* A1 = (u16*)(p.ws + OFF_A1T); u16* A2 = (u16*)(p.ws + OFF_A2T); u16* A3 = (u16*)(p.ws + OFF_A3T);
    float2* TW = (float2*)(p.ws + OFF_TW); float2* RP = (float2*)(p.ws + OFF_ROPE);
    for (int e = bid * 256 + tid; e < 256 * 256; e += G * 256) {
      int m = e >> 8, k = e & 255; int ro = (m >> 5) & 1, k1 = (m >> 6) * 32 + (m & 31), ri = k >> 7, n1 = k & 127;
      float ang = (float)((n1 * k1) & 127) / 64.f; float c = cospif(ang), s = sinpif(ang);
      float v = (ro == 0) ? (ri == 0 ? c : s) : (ri == 0 ? -s : c);
      A1[e] = f2bf(v);
    }
    for (int e = bid * 256 + tid; e < 128 * 256; e += G * 256) {
      int k2 = e >> 8, k = e & 255; int ri = k >> 7, n2 = k & 127;
      float ang = (float)((n2 * k2) & 127) / 64.f;
      A2[e] = f2bf(ri ? sinpif(ang) : cospif(ang));
    }
    for (int e = bid * 256 + tid; e < 256 * 512; e += G * 256) {
      int kk = e >> 9, k = e & 511; int ri = k >> 8, n = k & 255;
      float ang = (float)((n * kk) & 255) / 128.f;
      A3[e] = f2bf(ri ? sinpif(ang) : cospif(ang));
    }
    for (int e = bid * 256 + tid; e < 16384; e += G * 256) { float ang = (float)e / 8192.f; TW[e] = make_float2(cospif(ang), sinpif(ang)); }
    for (int e = bid * 256 + tid; e < 256 * 8; e += G * 256) {
      int pos = e >> 3, j = e & 7;
      const float invt[8] = {1.f, 0.31622776601683794f, 0.1f, 0.031622776601683794f, 0.01f, 0.0031622776601683794f, 0.001f, 0.00031622776601683794f};
      float inv = j == 0 ? invt[0] : j == 1 ? invt[1] : j == 2 ? invt[2] : j == 3 ? invt[3] : j == 4 ? invt[4] : j == 5 ? invt[5] : j == 6 ? invt[6] : invt[7];
      float angf = (float)pos * inv;
      double tt = (double)angf * 0.15915494309189535;
      tt -= floor(tt);
      float a2 = (float)(2.0 * tt);
      RP[e] = make_float2(cospif(a2), sinpif(a2));
    }
  }
  {
    float* sl = (float*)lds;
    float* part = sl + 3 * 1024;
    float* modo = (float*)(p.ws + OFF_MOD);
    const int lane = tid & 63, wave = tid >> 6;
    for (int it = bid; it < NLAYER * 96; it += G) {
      const int l = it / 96, cgp = it % 96;
      __syncthreads();
      for (int e = tid; e < 3 * 1024; e += 256) {
        int mi = e >> 10, k = e & 1023; float v = mi < 2 ? p.c[mi * 1024 + k] : p.c_ctx[k];
        sl[e] = v * sigmoidf_(v);
      }
      __syncthreads();
      const int j = cgp * 64 + lane;
      const float* wp = p.w_mod + ((size_t)l * 1024 + wave * 256) * 6144 + j;
      float a0 = 0.f, a1 = 0.f, a2 = 0.f;
#pragma unroll 8
      for (int k = 0; k < 256; ++k) {
        float w = wp[(size_t)k * 6144];
        a0 += sl[wave * 256 + k] * w; a1 += sl[1024 + wave * 256 + k] * w; a2 += sl[2048 + wave * 256 + k] * w;
      }
      part[(wave * 3 + 0) * 64 + lane] = a0; part[(wave * 3 + 1) * 64 + lane] = a1; part[(wave * 3 + 2) * 64 + lane] = a2;
      __syncthreads();
      if (tid < 192) {
        int mi = tid >> 6, ln = tid & 63;
        float s = part[(0 * 3 + mi) * 64 + ln] + part[(1 * 3 + mi) * 64 + ln] + part[(2 * 3 + mi) * 64 + ln] + part[(3 * 3 + mi) * 64 + ln];
        int jj = cgp * 64 + ln;
        modo[(size_t)(l * 3 + mi) * 6144 + jj] = s + p.b_mod[l * 6144 + jj];
      }
    }
  }
  {
    constexpr int T_IN = 16 * 15, T_UQ = 4 * 12, T_UKV = 2 * 16, T_O = 8 * 16, T_1 = 16 * 64, T_2 = 64 * 16;
    constexpr int T_L = T_IN + T_UQ + T_UKV + T_O + T_1 + T_2;
    for (int it = bid; it < NLAYER * T_L; it += G) {
      const int l = it / T_L; int t = it % T_L;
      if (t < T_IN) { int kt = t / 15, nt = t % 15;
        prep_transpose_tile(p.w_in + (size_t)l * DM * 1184, 1184, kt * 64, 256 + nt * 64, 1184, Win + (size_t)l * NINP * DM, DM, 512 + nt * 64, kt * 64, nullptr, lds); continue; }
      t -= T_IN;
      if (t < T_UQ) { int kt = t / 12, nt = t % 12;
        prep_transpose_tile(p.w_uq + (size_t)l * 256 * 768, 768, kt * 64, nt * 64, 768, Wuq + (size_t)l * 768 * 256, 256, nt * 64, kt * 64, p.q_norm_g + l * 256, lds); continue; }
      t -= T_UQ;
      if (t < T_UKV) { int kt = t / 16, nt = t % 16;
        prep_transpose_tile(p.w_ukv + (size_t)l * 128 * 1024, 1024, kt * 64, nt * 64, 1024, Wukv + (size_t)l * 1024 * 256, 256, nt * 64, kt * 64, p.kv_norm_g + l * 128, lds); continue; }
      t -= T_UKV;
      if (t < T_O) { int kt = t / 16, nt = t % 16;
        prep_transpose_tile(p.w_o + (size_t)l * DM * DM, DM, 256 + kt * 64, nt * 64, DM, Wo + (size_t)l * DM * DM, DM, nt * 64, 256 + kt * 64, nullptr, lds); continue; }
      t -= T_O;
      if (t < T_1) { int kt = t / 64, nt = t % 64;
        prep_transpose_tile(p.w_mlp1 + (size_t)l * DM * DFF, DFF, kt * 64, nt * 64, DFF, W1 + (size_t)l * DFF * DM, DM, nt * 64, kt * 64, nullptr, lds); continue; }
      t -= T_1;
      { int kt = t / 16, nt = t % 16;
        prep_transpose_tile(p.w_mlp2 + (size_t)l * DFF * DM, DM, kt * 64, nt * 64, DM, W2 + (size_t)l * DM * DFF, DFF, nt * 64, kt * 64, nullptr, lds); }
    }
  }
  {
    float* Ws = (float*)lds;
    float* ct = Ws + 64 * 65;
    float* st = ct + 64;
    for (int it = bid; it < NLAYER * 4 * 16; it += G) {
      const int l = it >> 6, g = (it >> 4) & 3, kt = it & 15;
      __syncthreads();
      if (tid < 64) { float ang = (float)tid / 32.f; ct[tid] = cospif(ang); st[tid] = sinpif(ang); }
#pragma unroll
      for (int i = 0; i < 16; ++i) { int e = tid + 256 * i; int kk = e >> 6, c = e & 63; Ws[kk * 65 + c] = p.w_in[((size_t)l * DM + kt * 64 + kk) * 1184 + g * 64 + c]; }
      __syncthreads();
      const int kk = tid & 63;
      for (int mm = 0; mm < 16; ++mm) {
        const int m = (tid >> 6) + 4 * mm;
        float sr = 0.f, si = 0.f;
        for (int c = 0; c < 64; ++c) { float w = Ws[kk * 65 + c]; int q = (m * c) & 63; sr += w * ct[q]; si -= w * st[q]; }
        u16* dst = Win + (size_t)l * NINP * DM + (size_t)(g * 64 + m) * DM + kt * 64 + kk;
        dst[0] = f2bf(sr); dst[(size_t)256 * DM] = f2bf(si);
      }
    }
  }
  {
    float* Ps = (float*)lds;
    float* Qs = Ps + 32 * 68;
    const int ty = tid >> 4, tx = tid & 15;
    for (int it = bid; it < NLAYER * 2 * 4 * 16; it += G) {
      const int l = it >> 7, wh = (it >> 6) & 1, kt = (it >> 4) & 3, nt = it & 15;
      const float* P = (wh ? p.w_pw2 : p.w_fourier) + (size_t)l * 256 * 256;
      const float* Qm = p.w_o + (size_t)l * DM * DM + (size_t)(wh ? 768 : 0) * DM;
      float acc[4][4];
#pragma unroll
      for (int a = 0; a < 4; ++a)
#pragma unroll
        for (int b = 0; b < 4; ++b) acc[a][b] = 0.f;
      for (int j0 = 0; j0 < 256; j0 += 32) {
        __syncthreads();
#pragma unroll
        for (int i = 0; i < 8; ++i) { int e = tid + 256 * i; int kk = e >> 5, jj = e & 31; Ps[jj * 68 + kk] = P[(size_t)(kt * 64 + kk) * 256 + j0 + jj]; }
#pragma unroll
        for (int i = 0; i < 8; ++i) { int e = tid + 256 * i; int jj = e >> 6, nn = e & 63; Qs[jj * 64 + nn] = Qm[(size_t)(j0 + jj) * DM + nt * 64 + nn]; }
        __syncthreads();
#pragma unroll 8
        for (int jj = 0; jj < 32; ++jj) {
          const float4 a4 = *(const float4*)&Ps[jj * 68 + ty * 4]; const float4 b4 = *(const float4*)&Qs[jj * 64 + tx * 4];
          const float av[4] = {a4.x, a4.y, a4.z, a4.w}, bv[4] = {b4.x, b4.y, b4.z, b4.w};
#pragma unroll
          for (int a = 0; a < 4; ++a)
#pragma unroll
            for (int b = 0; b < 4; ++b) acc[a][b] += av[a] * bv[b];
        }
      }
#pragma unroll
      for (int b = 0; b < 4; ++b) {
        const int n = nt * 64 + tx * 4 + b, k = (wh ? 768 : 0) + kt * 64 + ty * 4;
        *(u32x2*)(Wo + (size_t)l * DM * DM + (size_t)n * DM + k) = pack4(acc[0][b], acc[1][b], acc[2][b], acc[3][b]);
      }
    }
  }
}

DI void phase_norm(const Params& p, int l, int which, char* lds_all) {
  const int tid = ltid(), lane = tid & 63, wave = tid >> 6;
  const float* g = (which ? p.norm2_g : p.norm1_g) + l * DM;
  u16* H = (u16*)(p.ws + OFF_H);
  float* cA = (float*)lds_all; float* cB = cA + 3 * 1024;
  __syncthreads();
  for (int e = tid; e < 3 * 1024; e += 512) {
    const int mi = e >> 10, c = e & 1023;
    cA[e] = g[c] * (1.f + modp(p, l, mi, which ? 4 : 1)[c]);
    cB[e] = modp(p, l, mi, which ? 3 : 0)[c];
  }
  __syncthreads();
  const int RS = gridDim.x * 8;
  const int NR = (which == 1 && l == NLAYER - 1) ? NLAT : NT;
  const int nslab = which ? (l < NLAYER - 1 ? 4 : 0) : (l > 0 ? 8 : 0);
  const float* sgate = which ? modp(p, l, 2, 2) : modp(p, l > 0 ? l - 1 : 0, 2, 5);
  for (int row0 = blockIdx.x * 8 + wave; row0 < NR; row0 += RS * 4) {
    float4 v[4][4]; float ss[4];
#pragma unroll
    for (int k = 0; k < 4; ++k) {
      const int row = row0 + k * RS;
      if (row < NR) {
        float* xr = xrow(p, row);
#pragma unroll
        for (int i = 0; i < 4; ++i) v[k][i] = *(const float4*)(xr + i * 256 + lane * 4);
        if (row >= NLAT && nslab > 0) {
          const float* sb = (const float*)(p.ws + OFF_SLAB) + (size_t)(row - NLAT) * DM;
#pragma unroll
          for (int i = 0; i < 4; ++i) {
            const int c = i * 256 + lane * 4;
            float4 a = make_float4(0.f, 0.f, 0.f, 0.f);
            for (int kc = 0; kc < nslab; ++kc) { const float4 t4 = *(const float4*)(sb + (size_t)kc * NCTX * DM + c); a.x += t4.x; a.y += t4.y; a.z += t4.z; a.w += t4.w; }
            const float4 gt = *(const float4*)(sgate + c);
            v[k][i].x += gt.x * a.x; v[k][i].y += gt.y * a.y; v[k][i].z += gt.z * a.z; v[k][i].w += gt.w * a.w;
            *(float4*)(xr + c) = v[k][i];
          }
        }
      } else {
#pragma unroll
        for (int i = 0; i < 4; ++i) v[k][i] = make_float4(0.f, 0.f, 0.f, 0.f);
      }
    }
#pragma unroll
    for (int k = 0; k < 4; ++k) {
      float a = 0.f;
#pragma unroll
      for (int i = 0; i < 4; ++i) a += v[k][i].x * v[k][i].x + v[k][i].y * v[k][i].y + v[k][i].z * v[k][i].z + v[k][i].w * v[k][i].w;
      ss[k] = wave_sum(a);
    }
#pragma unroll
    for (int k = 0; k < 4; ++k) {
      const int row = row0 + k * RS;
      if (row < NR) {
        const float rinv = rsqrtf(ss[k] * (1.f / DM) + EPS);
        const int mi = mod_index(row);
        if (which == 0 && lane < 2) ((float*)(p.ws + OFF_SSQ))[(size_t)row * 2 + lane] = 0.f;
#pragma unroll
        for (int i = 0; i < 4; ++i) {
          const int c = i * 256 + lane * 4;
          const float4 a4 = *(const float4*)(cA + mi * 1024 + c), b4 = *(const float4*)(cB + mi * 1024 + c);
          *(u32x2*)(H + (size_t)row * DM + c) = pack4(v[k][i].x * rinv * a4.x + b4.x, v[k][i].y * rinv * a4.y + b4.y,
                                                     v[k][i].z * rinv * a4.z + b4.z, v[k][i].w * rinv * a4.w + b4.w);
        }
      }
    }
  }
}

DI void phase_win(const Params& p, int l, LAS char* lds) {
  const u16* Win = (const u16*)(p.ws + OFF_WIN) + (size_t)l * NINP * DM;
  const u16* H = (const u16*)(p.ws + OFF_H);
  u16* Z = (u16*)(p.ws + OFF_Z); u16* Kb = (u16*)(p.ws + OFF_K);
  const float2* RP = (const float2*)(p.ws + OFF_ROPE);
  for (int t = blockIdx.x; t < (NT / 256) * 6; t += gridDim.x) {
    const int tt = t / 6, ft = t % 6;
    const int tn = t + gridDim.x; const bool hn = tn < (NT / 256) * 6;
    f32x4 acc[2][2][4][2];
    gemm256(Win + (size_t)ft * 256 * DM, DM, H + (size_t)tt * 256 * DM, DM, DM / 64, lds, acc, t != (int)blockIdx.x,
            hn ? Win + (size_t)(tn % 6) * 256 * DM : nullptr, hn ? H + (size_t)(tn / 6) * 256 * DM : nullptr);
    G_LANE_IDS
    G_FOREACH(acc, {
      const int F = ft * 256 + f0, T = tt * 256 + tok;
      if (F < 896 || (F >= 928 && F < ZW)) *(u32x2*)(Z + (size_t)T * ZW + F) = pack4(v[0], v[1], v[2], v[3]);
    });
    if (ft == 2 || ft == 3) {
      float* ssq = (float*)(p.ws + OFF_SSQ);
#pragma unroll
      for (int bj = 0; bj < 2; ++bj)
#pragma unroll
        for (int n = 0; n < 2; ++n) {
          float a = 0.f;
#pragma unroll
          for (int ai = 0; ai < 2; ++ai)
#pragma unroll
            for (int m = 0; m < 4; ++m) {
              if (ft == 3 && ai == 1) continue;
              const f32x4 v = acc[ai][bj][m][n];
              a += v[0] * v[0] + v[1] * v[1] + v[2] * v[2] + v[3] * v[3];
            }
          a += shx(a, 16); a += shx(a, 32);
          if (fq == 0) atomicAdd(ssq + (size_t)(tt * 256 + bj * 128 + wc * 32 + n * 16 + fr) * 2 + (ft - 2), a);
        }
    }
    if (ft == 3 && wr == 0) {
#pragma unroll
      for (int bj = 0; bj < 2; ++bj)
#pragma unroll
        for (int n = 0; n < 2; ++n) {
          const int T = tt * 256 + bj * 128 + wc * 32 + n * 16 + fr;
          int b, key, pos; bool lat; tok_info(T, b, key, lat, pos);
          f32x4 x1 = acc[1][bj][0][n], x2 = acc[1][bj][1][n];
          if (lat) {
            const int rowp = pos >> 6, colp = pos & 63;
#pragma unroll
            for (int j = 0; j < 4; ++j) {
              const int i = fq * 4 + j;
              const float2 cs = (i < 8) ? RP[rowp * 8 + i] : RP[colp * 8 + (i - 8)];
              const float a = x1[j], c = x2[j];
              x1[j] = a * cs.x - c * cs.y; x2[j] = a * cs.y + c * cs.x;
            }
          }
          const u32x2 p1 = pack4(x1[0], x1[1], x1[2], x1[3]), p2 = pack4(x2[0], x2[1], x2[2], x2[3]);
#pragma unroll
          for (int hh = 0; hh < NH; ++hh) {
            u16* kd = Kb + ((size_t)(b * NH + hh) * NKEYS + key) * 96 + 64 + fq * 4;
            *(u32x2*)kd = p1; *(u32x2*)(kd + 16) = p2;
          }
        }
    }
  }
}

DI void mid_up256(const Params& p, int l, int t, int tn, LAS char* lds) {
  const u16* Zb = (const u16*)(p.ws + OFF_Z);
  const float* ssq = (const float*)(p.ws + OFF_SSQ);
  f32x4 acc[2][2][4][2];
  const bool isq = t < (NT / 256) * 3;
  const int u = isq ? t : t - (NT / 256) * 3;
  const int tt = isq ? u / 3 : u / 4, ft = isq ? u % 3 : u % 4;
  auto ptrs = [&](int ti, const u16*& a_, const u16*& b_) {
    const bool q_ = ti < (NT / 256) * 3; const int u_ = q_ ? ti : ti - (NT / 256) * 3; const int tt_ = q_ ? u_ / 3 : u_ / 4, ft_ = q_ ? u_ % 3 : u_ % 4;
    a_ = (q_ ? (const u16*)(p.ws + OFF_WUQ) + (size_t)l * 768 * 256 : (const u16*)(p.ws + OFF_WUKV) + (size_t)l * 1024 * 256) + (size_t)ft_ * 256 * 256;
    b_ = Zb + (size_t)tt_ * 256 * ZW + (q_ ? 512 : 768); };
  const u16* a0; const u16* b0; ptrs(t, a0, b0);
  const u16* a1 = nullptr; const u16* b1 = nullptr; if (tn >= 0) ptrs(tn, a1, b1);
  gemm256(a0, 256, b0, ZW, 4, lds, acc, t != (int)blockIdx.x, a1, b1);
  G_LANE_IDS
  if (isq) {
    u16* Q = (u16*)(p.ws + OFF_Q);
    const float2* RP = (const float2*)(p.ws + OFF_ROPE);
#pragma unroll
    for (int bj = 0; bj < 2; ++bj)
#pragma unroll
      for (int n = 0; n < 2; ++n) {
        const int T = tt * 256 + bj * 128 + wc * 32 + n * 16 + fr;
        const float sc = rsqrtf(ssq[(size_t)T * 2] * (1.f / 256.f) + EPS) * QSCALE;
        const bool lat = T < NLAT;
        const int pos = T & (SEQ - 1), rowp = pos >> 6, colp = pos & 63;
#pragma unroll
        for (int ai = 0; ai < 2; ++ai)
#pragma unroll
          for (int mp = 0; mp < 4; mp += 2) {
            f32x4 x1 = acc[ai][bj][mp][n] * sc, x2 = acc[ai][bj][mp + 1][n] * sc;
            const int b16 = ft * 16 + ai * 8 + wr * 4 + mp;
            if ((b16 % 6) == 4 && lat) {
#pragma unroll
              for (int j = 0; j < 4; ++j) {
                const int i = fq * 4 + j;
                const float2 cs = (i < 8) ? RP[rowp * 8 + i] : RP[colp * 8 + (i - 8)];
                const float a = x1[j], c = x2[j];
                x1[j] = a * cs.x - c * cs.y; x2[j] = a * cs.y + c * cs.x;
              }
            }
            u16* qd = Q + (size_t)T * 768 + b16 * 16 + fq * 4;
            *(u32x2*)qd = pack4(x1[0], x1[1], x1[2], x1[3]);
            *(u32x2*)(qd + 16) = pack4(x2[0], x2[1], x2[2], x2[3]);
          }
      }
  } else {
    u16* Kb = (u16*)(p.ws + OFF_K); u16* Vt = (u16*)(p.ws + OFF_VT);
#pragma unroll
    for (int bj = 0; bj < 2; ++bj)
#pragma unroll
      for (int n = 0; n < 2; ++n) {
        const int T = tt * 256 + bj * 128 + wc * 32 + n * 16 + fr;
        const float sc = rsqrtf(ssq[(size_t)T * 2 + 1] * (1.f / 128.f) + EPS);
        int b, key, pos; bool lat; tok_info(T, b, key, lat, pos);
        const int kp = vpos(key);
#pragma unroll
        for (int ai = 0; ai < 2; ++ai) {
          const int hh = ft * 2 + ai;
#pragma unroll
          for (int m = 0; m < 4; ++m) {
            const f32x4 v = acc[ai][bj][m][n] * sc;
            const int within = wr * 64 + m * 16 + fq * 4;
            if (wr == 0) {
              *(u32x2*)(Kb + ((size_t)(b * NH + hh) * NKEYS + key) * 96 + within) = pack4(v[0], v[1], v[2], v[3]);
            } else {
              u16* vd = Vt + ((size_t)(b * NH + hh) * 64 + (within - 64)) * NKEYS + kp;
              vd[0] = f2bf(v[0]); vd[NKEYS] = f2bf(v[1]); vd[2 * NKEYS] = f2bf(v[2]); vd[3 * NKEYS] = f2bf(v[3]);
            }
          }
        }
      }
  }
}
DI void mid_conv(const Params& p, int l, int it, char* lds) {
  const int tid = ltid() & 255, lane = tid & 63, wave = tid >> 6;
  const int row0 = it * 32;
  int seqbase, n0, N;
  if (row0 < NLAT) { seqbase = row0 & ~(SEQ - 1); n0 = row0 & (SEQ - 1); N = SEQ; }
  else { int rr = row0 - NLAT; seqbase = NLAT + (rr & ~255); n0 = rr & 255; N = CTXL; }
  const u16* Z = (const u16*)(p.ws + OFF_Z);
  u16* CAT = (u16*)(p.ws + OFF_CAT);
  float* us = (float*)lds;
  const int c = tid;
  __syncthreads();
#pragma unroll 1
  for (int r0 = 0; r0 < 64; r0 += 8) {
    u16 av[8], gv[8];
#pragma unroll
    for (int k = 0; k < 8; ++k) {
      int n = n0 - 15 + r0 + k; n = n < 0 ? 0 : (n >= N ? N - 1 : n);
      const u16* zr = Z + (size_t)(seqbase + n) * ZW;
      av[k] = zr[928 + c]; gv[k] = zr[1184 + c];
    }
    __builtin_amdgcn_sched_barrier(0);
#pragma unroll
    for (int k = 0; k < 8; ++k) {
      const int rr = r0 + k, n = n0 - 15 + rr;
      const float a = bf2f(av[k]), g = bf2f(gv[k]);
      const float u = (n >= 0 && n < N) ? a * sigmoidf_(g) : 0.f;
      if (rr < 62) us[rr * 256 + c] = u;
    }
  }
  float w[31];
#pragma unroll
  for (int j = 0; j < 31; ++j) w[j] = p.w_dw[((size_t)l * 31 + j) * 256 + c];
  const float bias = p.b_dw[l * 256 + c];
#pragma unroll 1
  for (int t0 = 0; t0 < 32; t0 += 8) {
    float acc[8];
#pragma unroll
    for (int o = 0; o < 8; ++o) acc[o] = bias;
#pragma unroll
    for (int rr = 0; rr < 38; ++rr) {
      const float u = us[(t0 + rr) * 256 + c];
#pragma unroll
      for (int o = 0; o < 8; ++o) { const int j = rr - o; if (j >= 0 && j < 31) acc[o] += w[j] * u; }
    }
#pragma unroll
    for (int o = 0; o < 8; ++o) us[(t0 + o) * 256 + c] = acc[o];
  }
  __syncthreads();
  const float4 lg = *(const float4*)(p.conv_ln_g + l * 256 + lane * 4), lb = *(const float4*)(p.conv_ln_b + l * 256 + lane * 4);
#pragma unroll
  for (int tt = 0; tt < 8; ++tt) {
    const int t = wave * 8 + tt;
    const float4 x = *(const float4*)(us + t * 256 + lane * 4);
    const float mu = wave_sum(x.x + x.y + x.z + x.w) * (1.f / 256.f);
    const float d0 = x.x - mu, d1 = x.y - mu, d2 = x.z - mu, d3 = x.w - mu;
    const float var = wave_sum(d0 * d0 + d1 * d1 + d2 * d2 + d3 * d3) * (1.f / 256.f);
    const float ri = rsqrtf(var + EPS);
    float y0 = d0 * ri * lg.x + lb.x, y1 = d1 * ri * lg.y + lb.y, y2 = d2 * ri * lg.z + lb.z, y3 = d3 * ri * lg.w + lb.w;
    y0 *= sigmoidf_(y0); y1 *= sigmoidf_(y1); y2 *= sigmoidf_(y2); y3 *= sigmoidf_(y3);
    *(u32x2*)(CAT + (size_t)(row0 + t) * DM + 768 + lane * 4) = pack4(y0, y1, y2, y3);
  }
}
DI void mid_fft1(const Params& p, int t, char* lds) {
  const int tid = ltid() & 255, lane = tid & 63, wave = tid >> 6, r = lane & 31, h = lane >> 5, wa = wave >> 1, wb = wave & 1;
  const int ntile = t & 1, mt = (t >> 1) & 1, n2 = (t >> 2) & 127, b = t >> 9;
  const u16* A1 = (const u16*)(p.ws + OFF_A1T) + (size_t)mt * 128 * 256;
  const u16* Z = (const u16*)(p.ws + OFF_Z);
  u16* Y = (u16*)(p.ws + OFF_Y);
  const float2* TW = (const float2*)(p.ws + OFF_TW);
  f32x16 acc[2][2]; float rinv[2];
  gemm128<1, false>(A1, 256, [&](int k) { return Z + (size_t)(b * SEQ + 128 * (k & 127) + n2) * ZW + (k >> 7) * 256 + ntile * 128; }, 256, lds, acc, rinv);
#pragma unroll
  for (int j = 0; j < 2; ++j) {
    const int ch = ntile * 128 + wb * 64 + j * 32 + r;
#pragma unroll
    for (int q = 0; q < 16; ++q) {
      const int k1 = mt * 64 + wa * 32 + crow(q, h);
      const float2 tw = TW[n2 * k1];
      const float yr = acc[0][j][q], yi = acc[1][j][q];
      u16* dst = Y + ((size_t)(b * 128 + k1) * 128 + n2) * 512 + ch;
      dst[0] = f2bf(yr * tw.x + yi * tw.y);
      dst[256] = f2bf(yi * tw.x - yr * tw.y);
    }
  }
}
DI void mid_ctxdft(const Params& p, int t, char* lds) {
  const int tid = ltid() & 255, lane = tid & 63, wave = tid >> 6, r = lane & 31, h = lane >> 5, wa = wave >> 1, wb = wave & 1;
  const int ntile = t & 1, mt = (t >> 1) & 1, b = t >> 2;
  const u16* A3 = (const u16*)(p.ws + OFF_A3T) + (size_t)mt * 128 * 512;
  const u16* Z = (const u16*)(p.ws + OFF_Z);
  u16* CAT = (u16*)(p.ws + OFF_CAT);
  f32x16 acc[2][2]; float rinv[2];
  gemm128<1, false>(A3, 512, [&](int k) { return Z + (size_t)(NLAT + b * 256 + (k & 255)) * ZW + (k >> 8) * 256 + ntile * 128; }, 512, lds, acc, rinv);
#pragma unroll
  for (int i = 0; i < 2; ++i)
#pragma unroll
    for (int j = 0; j < 2; ++j) {
      const int ch = ntile * 128 + wb * 64 + j * 32 + r;
#pragma unroll
      for (int q = 0; q < 16; ++q) {
        const int kk = mt * 128 + wa * 64 + i * 32 + crow(q, h);
        CAT[(size_t)(NLAT + b * 256 + kk) * DM + ch] = f2bf(acc[i][j][q] * (1.f / 128.f));
      }
    }
}
constexpr int N_UP256 = (NT / 256) * 7, N_CONV = NT / 32, N_FFT1 = 2 * 128 * 4, N_CDFT = 8;
DI void phase_mid(const Params& p, int l, char* lds, LAS char* lds3) {
  for (int it = blockIdx.x; it < N_UP256; it += gridDim.x) mid_up256(p, l, it, (it + (int)gridDim.x < N_UP256) ? it + (int)gridDim.x : -1, lds3);
  __syncthreads();
  const int G2 = vgrid(), rot = ((N_UP256 % (int)gridDim.x) * 2) % G2;
  for (int it = (vbid() - rot + G2) % G2; it < N_CONV + N_FFT1 + N_CDFT; it += G2) {
    int t = it;
    if (t < N_CDFT) { mid_ctxdft(p, t, lds); continue; }
    t -= N_CDFT;
    if (t < N_FFT1) { mid_fft1(p, t, lds); continue; }
    t -= N_FFT1;
    mid_conv(p, l, t, lds);
  }
}

DI void attn_fft2(const Params& p, int t, char* lds) {
  const int tid = ltid() & 255, lane = tid & 63, wave = tid >> 6, r = lane & 31, h = lane >> 5, wa = wave >> 1, wb = wave & 1;
  const int ntile = t & 1, k1 = (t >> 1) & 127, b = t >> 8;
  const u16* A2 = (const u16*)(p.ws + OFF_A2T);
  const u16* Y = (const u16*)(p.ws + OFF_Y);
  u16* CAT = (u16*)(p.ws + OFF_CAT);
  f32x16 acc[2][2]; float rinv[2];
  gemm128<1, false>(A2, 256, [&](int k) { return Y + ((size_t)(b * 128 + k1) * 128 + (k & 127)) * 512 + (k >> 7) * 256 + ntile * 128; }, 256, lds, acc, rinv);
#pragma unroll
  for (int i = 0; i < 2; ++i)
#pragma unroll
    for (int j = 0; j < 2; ++j) {
      const int ch = ntile * 128 + wb * 64 + j * 32 + r;
#pragma unroll
      for (int q = 0; q < 16; ++q) {
        const int k2 = wa * 64 + i * 32 + crow(q, h);
        CAT[(size_t)(b * SEQ + k1 + 128 * k2) * DM + ch] = f2bf(acc[i][j][q] * (1.f / 1024.f));
      }
    }
}
constexpr int AST = 40960;
DI void attn8(const u16* __restrict__ Qp, const u16* __restrict__ Kp, const u16* __restrict__ Vp, int nkeys, u16* __restrict__ Op, LAS char* lds) {
  const int tid = ltid(), wid = __builtin_amdgcn_readfirstlane(tid >> 6), lane = tid & 63, r = lane & 31, h = lane >> 5;
  bf16x8 qf[6];
  {
    const u16* qrow = Qp + (size_t)(wid * 32 + r) * 768 + 8 * h;
#pragma unroll
    for (int s = 0; s < 6; ++s) qf[s] = *(const bf16x8*)(qrow + 16 * s);
  }
  const char* src[5];
#pragma unroll
  for (int i = 0; i < 5; ++i) {
    const int pce = wid * 5 + i;
    if (pce < 24) {
      const int byte = pce * 1024 + lane * 16, row = byte / 192, sl = (byte % 192) >> 4;
      src[i] = (const char*)Kp + row * 192 + ((sl ^ ((row >> 2) & 3)) << 4);
    } else {
      const int hv = (pce - 24) >> 3, byte = ((pce - 24) & 7) * 1024 + lane * 16, d = byte >> 7, sl = (byte & 127) >> 4;
      src[i] = (const char*)Vp + (size_t)d * (NKEYS * 2) + hv * 128 + ((sl ^ ((d >> 1) & 7)) << 4);
    }
  }
  auto issue = [&](int slot) {
#pragma unroll
    for (int i = 0; i < 5; ++i) {
      const int pce = wid * 5 + i;
      __builtin_amdgcn_global_load_lds((const unsigned*)src[i], (LAS unsigned*)(lds + slot * AST + pce * 1024), 16, 0, 0);
      src[i] += (pce < 24) ? 128 * 192 : 256;
    }
  };
  const int x2 = (r >> 2) & 3, y3 = (r >> 1) & 7;
  const int ko_e = r * 192 + ((h ^ x2) << 4), ko_o = r * 192 + (((2 + h) ^ x2) << 4);
  int vo[4];
#pragma unroll
  for (int sl = 0; sl < 4; ++sl) vo[sl] = r * 128 + (((2 * sl + h) ^ y3) << 4);
  f32x16 o0, o1;
#pragma unroll
  for (int q = 0; q < 16; ++q) { o0[q] = 0.f; o1[q] = 0.f; }
  float m_run = 0.f, l_run = 0.f;
  f32x16 negm;
#pragma unroll
  for (int q = 0; q < 16; ++q) negm[q] = 0.f;
  const int NST = nkeys / 128;
  asm volatile("s_waitcnt vmcnt(0) lgkmcnt(0)" ::: "memory");
  __builtin_amdgcn_s_barrier();
  issue(0);
  if (NST > 1) issue(1);
  int slot = 0;
  for (int t = 0; t < NST; ++t) {
    if (t + 1 < NST) asm volatile("s_waitcnt vmcnt(5)" ::: "memory"); else asm volatile("s_waitcnt vmcnt(0)" ::: "memory");
    __builtin_amdgcn_s_barrier();
    __builtin_amdgcn_sched_barrier(0);
    if (t + 2 < NST) { int s2 = slot + 2; if (s2 >= 3) s2 -= 3; issue(s2); }
    __builtin_amdgcn_sched_barrier(0);
    LAS const char* Sb = lds + slot * AST;
#pragma unroll
    for (int hv = 0; hv < 2; ++hv) {
      f32x16 s0, s1;
      bf16x8 ka0[6], ka1[6];
#pragma unroll
      for (int s = 0; s < 6; ++s) {
        const int ko = (s & 1) ? ko_o : ko_e;
        ka0[s] = *(const LAS bf16x8*)(Sb + (hv * 64) * 192 + (s >> 1) * 64 + ko);
        ka1[s] = *(const LAS bf16x8*)(Sb + (hv * 64 + 32) * 192 + (s >> 1) * 64 + ko);
      }
      __builtin_amdgcn_sched_barrier(0);
      s0 = MFMA(ka0[0], qf[0], negm); s1 = MFMA(ka1[0], qf[0], negm);
#pragma unroll
      for (int s = 1; s < 6; ++s) { s0 = MFMA(ka0[s], qf[s], s0); s1 = MFMA(ka1[s], qf[s], s1); }
      LAS const char* Vb = Sb + 24576 + hv * 8192;
      bf16x8 vf0[4], vf1[4];
#pragma unroll
      for (int sl = 0; sl < 4; ++sl) { vf0[sl] = *(const LAS bf16x8*)(Vb + vo[sl]); vf1[sl] = *(const LAS bf16x8*)(Vb + 32 * 128 + vo[sl]); }
      __builtin_amdgcn_sched_barrier(0);
      float mt_ = s0[0];
#pragma unroll
      for (int q = 1; q < 16; ++q) mt_ = fmaxf(mt_, s0[q]);
#pragma unroll
      for (int q = 0; q < 16; ++q) mt_ = fmaxf(mt_, s1[q]);
      mt_ = swap_max(mt_);
      const bool first = (hv == 0) && (t == 0);
      if (first || !__all(mt_ <= 8.f)) {
        const float delta = first ? mt_ : fmaxf(mt_, 0.f);
        const float alpha = first ? 1.f : __builtin_amdgcn_exp2f(-delta);
        m_run += delta;
        l_run *= alpha;
#pragma unroll
        for (int q = 0; q < 16; ++q) { o0[q] *= alpha; o1[q] *= alpha; s0[q] -= delta; s1[q] -= delta; negm[q] = -m_run; }
      }
      float ps = 0.f;
#pragma unroll
      for (int q = 0; q < 16; ++q) { s0[q] = __builtin_amdgcn_exp2f(s0[q]); ps += s0[q]; }
#pragma unroll
      for (int q = 0; q < 16; ++q) { s1[q] = __builtin_amdgcn_exp2f(s1[q]); ps += s1[q]; }
      l_run += ps;
      bf16x8 pf[4];
      {
        u32x4 w;
        w[0] = cvtpk(s0[0], s0[1]); w[1] = cvtpk(s0[2], s0[3]); w[2] = cvtpk(s0[4], s0[5]); w[3] = cvtpk(s0[6], s0[7]); pf[0] = __builtin_bit_cast(bf16x8, w);
        w[0] = cvtpk(s0[8], s0[9]); w[1] = cvtpk(s0[10], s0[11]); w[2] = cvtpk(s0[12], s0[13]); w[3] = cvtpk(s0[14], s0[15]); pf[1] = __builtin_bit_cast(bf16x8, w);
        w[0] = cvtpk(s1[0], s1[1]); w[1] = cvtpk(s1[2], s1[3]); w[2] = cvtpk(s1[4], s1[5]); w[3] = cvtpk(s1[6], s1[7]); pf[2] = __builtin_bit_cast(bf16x8, w);
        w[0] = cvtpk(s1[8], s1[9]); w[1] = cvtpk(s1[10], s1[11]); w[2] = cvtpk(s1[12], s1[13]); w[3] = cvtpk(s1[14], s1[15]); pf[3] = __builtin_bit_cast(bf16x8, w);
      }
#pragma unroll
      for (int sl = 0; sl < 4; ++sl) { o0 = MFMA(vf0[sl], pf[sl], o0); o1 = MFMA(vf1[sl], pf[sl], o1); }
    }
    slot = (slot == 2) ? 0 : slot + 1;
  }
  const float linv = 1.f / swap_sum(l_run);
  u16* orow = Op + (size_t)(wid * 32 + r) * DM;
#pragma unroll
  for (int g = 0; g < 4; ++g) {
    *(u32x2*)(orow + 8 * g + 4 * h) = pack4(o0[4 * g] * linv, o0[4 * g + 1] * linv, o0[4 * g + 2] * linv, o0[4 * g + 3] * linv);
    *(u32x2*)(orow + 32 + 8 * g + 4 * h) = pack4(o1[4 * g] * linv, o1[4 * g + 1] * linv, o1[4 * g + 2] * linv, o1[4 * g + 3] * linv);
  }
}
constexpr int N_FFT2 = 2 * 128 * 2, N_ACTX = 2 * NH, N_ALAT = 2 * NH * 64;
DI void phase_attn(const Params& p, char* lds, LAS char* lds3) {
  const u16* Q = (const u16*)(p.ws + OFF_Q); const u16* Kb = (const u16*)(p.ws + OFF_K); const u16* Vt = (const u16*)(p.ws + OFF_VT);
  u16* CAT = (u16*)(p.ws + OFF_CAT);
  for (int it = vbid(); it < N_FFT2; it += vgrid()) attn_fft2(p, it, lds);
  __syncthreads();
  for (int it = blockIdx.x; it < N_ACTX + N_ALAT; it += gridDim.x) {
    int t = it;
    if (t < N_ACTX) {
      const int hh = t & 7, b = t >> 3;
      const int row0 = NLAT + b * 256;
      attn8(Q + (size_t)row0 * 768 + hh * 96, Kb + (size_t)(b * NH + hh) * NKEYS * 96, Vt + (size_t)(b * NH + hh) * 64 * NKEYS, CTXL,
            CAT + (size_t)row0 * DM + 256 + hh * 64, lds3);
      continue;
    }
    t -= N_ACTX;
    {
      const int qt = t & 63, hh = (t >> 6) & 7, b = t >> 9;
      const int row0 = b * SEQ + qt * 256;
      attn8(Q + (size_t)row0 * 768 + hh * 96, Kb + (size_t)(b * NH + hh) * NKEYS * 96, Vt + (size_t)(b * NH + hh) * 64 * NKEYS, NKEYS,
            CAT + (size_t)row0 * DM + 256 + hh * 64, lds3);
    }
  }
}

template <int KFULL, int KS>
DI void resid_gemm_phase(const Params& p, int l, const u16* __restrict__ W, const u16* __restrict__ X, int gate_chunk, LAS char* lds) {
  constexpr int NWHOLE = (NLAT / 256) * 4, KC = KFULL / KS;
  const int nitems = NWHOLE + ((l == NLAYER - 1) ? 0 : 8 * KS);
  float* slab = (float*)(p.ws + OFF_SLAB);
  for (int t = blockIdx.x; t < nitems; t += gridDim.x) {
    f32x4 acc[2][2][4][2];
    const bool split = t >= NWHOLE;
    auto tile_of = [&](int ti, int& tile_, int& kc_) {
      const int u_ = ti - NWHOLE, bx = ti & 7, bs = (ti & 255) >> 3, rnd = ti >> 8;
      tile_ = ti >= NWHOLE ? NWHOLE + u_ / KS : (rnd * 64 + bx * 8 + (bs >> 2)) * 4 + (bs & 3); kc_ = ti >= NWHOLE ? u_ % KS : 0; };
    int tile, kc; tile_of(t, tile, kc);
    const int tt = tile / 4, ft = tile % 4;
    const int tn = t + gridDim.x; const bool hn = tn < nitems;
    int tile_n = 0, kc_n = 0; if (hn) tile_of(tn, tile_n, kc_n);
    gemm256(W + (size_t)ft * 256 * KFULL + kc * KC, KFULL, X + (size_t)tt * 256 * KFULL + kc * KC, KFULL, split ? KC / 64 : KFULL / 64, lds, acc, t != (int)blockIdx.x,
            hn ? W + (size_t)(tile_n % 4) * 256 * KFULL + kc_n * KC : nullptr, hn ? X + (size_t)(tile_n / 4) * 256 * KFULL + kc_n * KC : nullptr);
    G_LANE_IDS
    if (split) {
      float* sb = slab + (size_t)kc * NCTX * DM;
      G_FOREACH(acc, {
        const int F = ft * 256 + f0, T = tt * 256 + tok - NLAT;
        *(float4*)(sb + (size_t)T * DM + F) = make_float4(v[0], v[1], v[2], v[3]);
      });
    } else {
      const float* gate = modp(p, l, mod_index(tt * 256), gate_chunk);
      G_FOREACH(acc, {
        const int F = ft * 256 + f0, T = tt * 256 + tok;
        float* xr = xrow(p, T) + F;
        const float4 gt = *(const float4*)(gate + F);
        float4 xv = *(float4*)xr;
        xv.x += gt.x * v[0]; xv.y += gt.y * v[1]; xv.z += gt.z * v[2]; xv.w += gt.w * v[3];
        *(float4*)xr = xv;
      });
    }
  }
}
constexpr int KS_WO = 4, KS_M2 = 8;
DI void phase_wo(const Params& p, int l, LAS char* lds) {
  resid_gemm_phase<DM, KS_WO>(p, l, (const u16*)(p.ws + OFF_WO) + (size_t)l * DM * DM, (const u16*)(p.ws + OFF_CAT), 2, lds);
}
DI void phase_mlp1(const Params& p, int l, LAS char* lds) {
  const u16* W1 = (const u16*)(p.ws + OFF_W1) + (size_t)l * DFF * DM;
  const u16* H = (const u16*)(p.ws + OFF_H);
  u16* A1 = (u16*)(p.ws + OFF_A1);
  const int ntt = (l == NLAYER - 1) ? NLAT / 256 : NT / 256;
  for (int t = blockIdx.x; t < ntt * 16; t += gridDim.x) {
    const int tt = t / 16, ft = t % 16;
    const int tn = t + gridDim.x; const bool hn = tn < ntt * 16;
    f32x4 acc[2][2][4][2];
    gemm256(W1 + (size_t)ft * 256 * DM, DM, H + (size_t)tt * 256 * DM, DM, DM / 64, lds, acc, t != (int)blockIdx.x,
            hn ? W1 + (size_t)(tn % 16) * 256 * DM : nullptr, hn ? H + (size_t)(tn / 16) * 256 * DM : nullptr);
    G_LANE_IDS
    G_FOREACH(acc, {
      const int F = ft * 256 + f0, T = tt * 256 + tok;
      const float a = fmaxf(v[0], 0.f), b = fmaxf(v[1], 0.f), c = fmaxf(v[2], 0.f), d = fmaxf(v[3], 0.f);
      *(u32x2*)(A1 + (size_t)T * DFF + F) = pack4(a * a, b * b, c * c, d * d);
    });
  }
}
DI void phase_mlp2(const Params& p, int l, LAS char* lds) {
  resid_gemm_phase<DFF, KS_M2>(p, l, (const u16*)(p.ws + OFF_W2) + (size_t)l * DM * DFF, (const u16*)(p.ws + OFF_A1), 5, lds);
}
DI void phase_final(const Params& p) {
  const int tid = ltid(), lane = tid & 63, wave = tid >> 6;
  const int RS = gridDim.x * 8;
  float4 g4[4];
#pragma unroll
  for (int i = 0; i < 4; ++i) g4[i] = *(const float4*)(p.final_norm_g + i * 256 + lane * 4);
  for (int row0 = blockIdx.x * 8 + wave; row0 < NLAT; row0 += RS * 4) {
    float4 v[4][4]; float ss[4];
#pragma unroll
    for (int k = 0; k < 4; ++k) {
      const int row = row0 + k * RS;
      const float* xr = p.out + (size_t)(row < NLAT ? row : row0) * DM;
#pragma unroll
      for (int i = 0; i < 4; ++i) v[k][i] = *(const float4*)(xr + i * 256 + lane * 4);
    }
#pragma unroll
    for (int k = 0; k < 4; ++k) {
      float a = 0.f;
#pragma unroll
      for (int i = 0; i < 4; ++i) a += v[k][i].x * v[k][i].x + v[k][i].y * v[k][i].y + v[k][i].z * v[k][i].z + v[k][i].w * v[k][i].w;
      ss[k] = wave_sum(a);
    }
#pragma unroll
    for (int k = 0; k < 4; ++k) {
      const int row = row0 + k * RS;
      if (row < NLAT) {
        const float rinv = rsqrtf(ss[k] * (1.f / DM) + EPS);
        float* xr = p.out + (size_t)row * DM;
#pragma unroll
        for (int i = 0; i < 4; ++i)
          *(float4*)(xr + i * 256 + lane * 4) = make_float4(v[k][i].x * rinv * g4[i].x, v[k][i].y * rinv * g4[i].y, v[k][i].z * rinv * g4[i].z, v[k][i].w * rinv * g4[i].w);
      }
    }
  }
}

constexpr int N_PHASES = 2 + 8 * NLAYER;
DI void run_phase(const Params& p, int ph, char* lds_all) {
#define HLDS (lds_all + (ltid() >> 8) * 73728)
  LAS char* lds3 = (LAS char*)lds_all;
  if (ph == 0) { phase_prep(p, HLDS); return; }
  if (ph == N_PHASES - 1) { phase_final(p); return; }
  const int l = (ph - 1) >> 3, s = (ph - 1) & 7;
  switch (s) {
    case 0: phase_norm(p, l, 0, lds_all); break;
    case 1: phase_win(p, l, lds3); break;
    case 2: phase_mid(p, l, HLDS, lds3); break;
    case 3: phase_attn(p, HLDS, lds3); break;
    case 4: phase_wo(p, l, lds3); break;
    case 5: phase_norm(p, l, 1, lds_all); break;
    case 6: phase_mlp1(p, l, lds3); break;
    default: phase_mlp2(p, l, lds3); break;
  }
}

extern __shared__ __attribute__((aligned(16))) char dyn_lds[];

#ifndef DIAG
#define DIAG 0
#endif
#ifndef DIAG_A
#define DIAG_A 0x008
#endif
#ifndef DIAG_B
#define DIAG_B 0x0C0
#endif
__global__ void __launch_bounds__(512, 2) mega_kernel(Params p) {
  cg::grid_group grid = cg::this_grid();
  volatile LAS unsigned* st = (volatile LAS unsigned*)((LAS char*)dyn_lds + LDS_PHASE);
  if (threadIdx.x == 0) { st[0] = 0u; st[1] = 0u; st[2] = 0u; st[3] = 0u; }
  __syncthreads();
  (void)xcd_barrier_post((unsigned*)(p.ws + OFF_BAR), st);
#define MK_XB() XcdBarrier{(unsigned*)(p.ws + OFF_BAR), xb_xcc_id(), (volatile LAS unsigned*)((LAS char*)dyn_lds + LDS_PHASE)}
#if DIAG
  unsigned long long* TS = (unsigned long long*)(p.ws + OFF_TS);
  const bool rec = (blockIdx.x == 0 && threadIdx.x == 0);
  if (rec) TS[0] = wall_clock64();
#endif
  for (int ph = 0; ph < N_PHASES; ++ph) {
    run_phase(p, ph, dyn_lds);
#if DIAG
    if (ph == 0) grid.sync(); else xcd_barrier(MK_XB());
    if (rec) TS[ph + 1] = wall_clock64();
#else
    if (ph == 0) grid.sync(); else if (ph + 1 < N_PHASES) xcd_barrier(MK_XB());
#endif
  }
#if DIAG
  if (blockIdx.x == 0) {
    unsigned long long ta = 0, tb = 0;
    for (int ph = 0; ph < N_PHASES; ++ph) {
      const int type = ph == 0 ? 8 : (ph == N_PHASES - 1 ? 9 : ((ph - 1) & 7));
      const unsigned long long d = TS[ph + 1] - TS[ph];
      if ((DIAG_A >> type) & 1) ta += d;
      if ((DIAG_B >> type) & 1) tb += d;
    }
    const float vb = (float)tb * 0.01f * 0.00002f;
    (void)ta;
    for (int i = threadIdx.x; i < 4096; i += 512) p.out[i] += (i == 0) ? 0.f : vb;
  }
#endif
}
#if MK_MULTI
__global__ void __launch_bounds__(512, 2) phase_kernel(Params p, int ph) { run_phase(p, ph, dyn_lds); }
#endif

extern "C" void kernel_launch(void* const* d_in, const int* in_sizes, int n_in, void* d_out, int out_size, void* d_ws, size_t ws_size,
                              hipStream_t stream) {
  Params p{};
  const float** f = (const float**)&p;
  for (int i = 0; i < 23; ++i) f[i] = (const float*)d_in[i];
  p.out = (float*)d_out;
  p.ws = (char*)d_ws;
  if (ws_size < WS_TOTAL) { fprintf(stderr, "kernel_launch: ws too small: %zu < %zu\n", ws_size, (size_t)WS_NEED); return; }
  static int grid_blocks = 0;
  if (!grid_blocks) {
    (void)hipFuncSetAttribute((const void*)mega_kernel, hipFuncAttributeMaxDynamicSharedMemorySize, LDS_BYTES);
#if MK_MULTI
    (void)hipFuncSetAttribute((const void*)phase_kernel, hipFuncAttributeMaxDynamicSharedMemorySize, LDS_BYTES);
#endif
    int dev = 0, cus = 0, per_cu = 0;
    (void)hipGetDevice(&dev);
    (void)hipDeviceGetAttribute(&cus, hipDeviceAttributeMultiprocessorCount, dev);
    (void)hipOccupancyMaxActiveBlocksPerMultiprocessor(&per_cu, mega_kernel, 512, LDS_BYTES);
    if (per_cu > 1) per_cu = 1;
    if (per_cu < 1) per_cu = 1;
    grid_blocks = cus * per_cu;
  }
#if MK_MULTI
  for (int ph = 0; ph < N_PHASES; ++ph) hipLaunchKernelGGL(phase_kernel, dim3(grid_blocks), dim3(512), LDS_BYTES, stream, p, ph);
#else
  (void)hipMemsetAsync((char*)d_ws + OFF_BAR, 0, XCD_BAR_WORDS * 4, stream);
  void* args[] = {&p};
  hipError_t e = hipLaunchCooperativeKernel((void*)mega_kernel, dim3(grid_blocks), dim3(512), args, LDS_BYTES, stream);
  if (e != hipSuccess) fprintf(stderr, "cooperative launch failed: %s (grid %d)\n", hipGetErrorString(e), grid_blocks);
#endif
}
```

```cpp
#include <hip/hip_runtime.h>
#include <hip/hip_cooperative_groups.h>
#include <cstdio>
#include <cstdint>
namespace cg = cooperative_groups;

#ifndef MK_MULTI
#define MK_MULTI 0
#endif

typedef unsigned short u16;
using bf16x8 = __attribute__((ext_vector_type(8))) short;
using f32x16 = __attribute__((ext_vector_type(16))) float;
using u32x4  = __attribute__((ext_vector_type(4))) unsigned;
using u32x2  = __attribute__((ext_vector_type(2))) unsigned;
#define DI __device__ __forceinline__
#define MFMA(a, b, c) __builtin_amdgcn_mfma_f32_32x32x16_bf16((a), (b), (c), 0, 0, 0)

constexpr int DM = 1024, NLAT = 32768, NCTX = 512, NT = NLAT + NCTX, SEQ = 16384, CTXL = 256, NLAYER = 4;
constexpr int ZW = 1440, NINP = 1536, DFF = 4096, NKEYS = SEQ + CTXL, NH = 8;
constexpr int MT = NT / 128;
constexpr float EPS = 1e-6f;
constexpr float QSCALE = 0.10206207261596575f * 1.4426950408889634f;

constexpr size_t al256(size_t x) { return (x + 255) / 256 * 256; }
constexpr size_t SZ_WIN = (size_t)NLAYER * NINP * DM * 2, SZ_WUQ = (size_t)NLAYER * 768 * 256 * 2, SZ_WUKV = (size_t)NLAYER * 1024 * 256 * 2;
constexpr size_t SZ_WO = (size_t)NLAYER * DM * DM * 2, SZ_W1 = (size_t)NLAYER * DFF * DM * 2, SZ_W2 = SZ_W1;
constexpr size_t OFF_WIN = 0, OFF_WUQ = OFF_WIN + SZ_WIN, OFF_WUKV = OFF_WUQ + SZ_WUQ, OFF_WO = OFF_WUKV + SZ_WUKV;
constexpr size_t OFF_W1 = OFF_WO + SZ_WO, OFF_W2 = OFF_W1 + SZ_W1, OFF_MOD = OFF_W2 + SZ_W2;
constexpr size_t OFF_A1T = OFF_MOD + al256((size_t)NLAYER * 3 * 6144 * 4);
constexpr size_t OFF_A2T = OFF_A1T + 256 * 256 * 2, OFF_A3T = OFF_A2T + 128 * 256 * 2, OFF_TW = OFF_A3T + 256 * 512 * 2;
constexpr size_t OFF_ROPE = OFF_TW + 16384 * 8, OFF_XRC = OFF_ROPE + 256 * 8 * 8, OFF_H = OFF_XRC + (size_t)NCTX * DM * 4;
constexpr size_t OFF_UNI = OFF_H + (size_t)NT * DM * 2;
constexpr size_t OFF_Z = OFF_UNI, OFF_Q = OFF_Z + (size_t)NT * ZW * 2, OFF_K = OFF_Q + (size_t)NT * 768 * 2;
constexpr size_t OFF_VT = OFF_K + (size_t)2 * NH * NKEYS * 96 * 2, OFF_CAT = OFF_VT + (size_t)2 * NH * 64 * NKEYS * 2;
constexpr size_t OFF_Y = OFF_CAT + (size_t)NT * DM * 2, UNI_END = OFF_Y + (size_t)2 * SEQ * 512 * 2;
constexpr size_t OFF_A1 = OFF_UNI, A1_END = OFF_A1 + (size_t)NT * DFF * 2;
constexpr size_t WS_NEED = UNI_END > A1_END ? UNI_END : A1_END;
constexpr int LDS_PHASE = 2 * 73728;
constexpr int LDS_BYTES = LDS_PHASE + 16;
constexpr size_t OFF_TS = al256(WS_NEED), OFF_BAR = OFF_TS + 4096, OFF_SLAB = al256(OFF_BAR + 3456 * 4), OFF_SSQ = OFF_SLAB + (size_t)8 * NCTX * DM * 4, WS_TOTAL = OFF_SSQ + (size_t)NT * 2 * 4;

struct Params {
  const float *x, *c, *ctx, *c_ctx, *w_mod, *b_mod, *norm1_g, *w_in, *q_norm_g, *w_uq, *kv_norm_g, *w_ukv, *w_fourier, *w_dw, *b_dw,
      *conv_ln_g, *conv_ln_b, *w_pw2, *w_o, *norm2_g, *w_mlp1, *w_mlp2, *final_norm_g;
  float* out;
  char* ws;
};

DI int ltid() { int t = threadIdx.x; asm volatile("" : "+v"(t)); return t; }
DI int vbid() { int h = __builtin_amdgcn_readfirstlane((int)(threadIdx.x >> 8)); asm volatile("" : "+s"(h)); return blockIdx.x * 2 + h; }
DI int vgrid() { return gridDim.x * 2; }
#define LAS __attribute__((address_space(3)))
using f32x4 = __attribute__((ext_vector_type(4))) float;
DI int crow(int reg, int h) { return (reg & 3) + 8 * (reg >> 2) + 4 * h; }
DI unsigned cvtpk(float lo, float hi) { unsigned r; asm("v_cvt_pk_bf16_f32 %0, %1, %2" : "=v"(r) : "v"(lo), "v"(hi)); return r; }
DI u16 f2bf(float x) { return (u16)(cvtpk(x, 0.f) & 0xffffu); }
DI float bf2f(u16 v) { return __uint_as_float(((unsigned)v) << 16); }
DI u32x2 pack4(float a, float b, float c, float d) { u32x2 r; r[0] = cvtpk(a, b); r[1] = cvtpk(c, d); return r; }
DI float shx(float v, int o) { const int ln = ltid() & 63; return __builtin_bit_cast(float, __builtin_amdgcn_ds_bpermute((ln ^ o) << 2, __builtin_bit_cast(int, v))); }
DI float wave_sum(float v) {
#pragma unroll
  for (int o = 32; o; o >>= 1) v += shx(v, o);
  return v;
}
DI float swap_max(float v) {
  auto rr = __builtin_amdgcn_permlane32_swap(__float_as_uint(v), __float_as_uint(v), false, false);
  return fmaxf(__uint_as_float(rr[0]), __uint_as_float(rr[1]));
}
DI float swap_sum(float v) {
  auto rr = __builtin_amdgcn_permlane32_swap(__float_as_uint(v), __float_as_uint(v), false, false);
  return __uint_as_float(rr[0]) + __uint_as_float(rr[1]);
}
DI float sigmoidf_(float x) { return 1.f / (1.f + __expf(-x)); }
DI float* xrow(const Params& p, int row) { return row < NLAT ? p.out + (size_t)row * DM : (float*)(p.ws + OFF_XRC) + (size_t)(row - NLAT) * DM; }
DI int mod_index(int row) { return row < NLAT ? (row >> 14) : 2; }
DI const float* modp(const Params& p, int l, int mi, int chunk) { return (const float*)(p.ws + OFF_MOD) + ((size_t)(l * 3 + mi) * 6 + chunk) * 1024; }
DI void tok_info(int m, int& b, int& key, bool& lat, int& pos) {
  if (m < NLAT) { b = m >> 14; pos = m & (SEQ - 1); key = CTXL + pos; lat = true; }
  else { int mm = m - NLAT; b = mm >> 8; pos = mm & 255; key = pos; lat = false; }
}
DI int vpos(int key) { return (key & ~12) | ((key & 4) << 1) | ((key & 8) >> 1); }


#define XB_TMO      128
#define XB_XCNT(j)  (256  + 64 * (j))
#define XB_XSUB(j)  (1280 + 64 * (j))
#define XB_XGEN(j)  (2304 + 64 * (j))
#define XB_TOP      3328
#define XB_TOPGEN   3392
#define XCD_BAR_WORDS 3456
#define XB_SPIN_CAP (1u << 22)
DI unsigned xb_ld(unsigned* p) { return __hip_atomic_load(p, __ATOMIC_RELAXED, __HIP_MEMORY_SCOPE_AGENT); }
DI unsigned xb_add(unsigned* p, unsigned v) { return __hip_atomic_fetch_add(p, v, __ATOMIC_RELAXED, __HIP_MEMORY_SCOPE_AGENT); }
DI unsigned xb_xcc_id() { return (unsigned)__builtin_amdgcn_s_getreg((3 << 11) | 20) & 0xFu; }
#define XB_SPIN(cond, bar) do { unsigned _sp = 0; while (cond) { __builtin_amdgcn_s_sleep(1); \
    if ((++_sp & 255u) == 0u) { if (xb_ld(&(bar)[XB_TMO])) break; if (_sp > XB_SPIN_CAP) { atomicAdd(&(bar)[XB_TMO], 1u); break; } } } } while (0)
struct XcdBarrier { unsigned* bar; unsigned x; volatile LAS unsigned* st; };
DI XcdBarrier xcd_barrier_post(unsigned* bar, volatile LAS unsigned* st) {
  XcdBarrier b; b.bar = bar; b.x = xb_xcc_id(); b.st = st;
  if (threadIdx.x == 0) (void)xb_add(&bar[XB_XCNT(b.x)], 1u);
  return b;
}
DI void xcd_barrier_complete(unsigned* bar, unsigned x, unsigned& nloc, unsigned& nx) {
  const unsigned G = gridDim.x * gridDim.y * gridDim.z;
  unsigned sum, cnt, mine, sp = 0u;
  for (;;) {
    sum = 0u; cnt = 0u; mine = 0u;
#pragma unroll
    for (unsigned j = 0; j < 16; ++j) { const unsigned c = xb_ld(&bar[XB_XCNT(j)]); sum += c; cnt += (c > 0u) ? 1u : 0u; mine = (j == x) ? c : mine; }
    if (sum == G) break;
    __builtin_amdgcn_s_sleep(1);
    if ((++sp & 255u) == 0u) { if (xb_ld(&bar[XB_TMO])) break; if (sp > XB_SPIN_CAP) { atomicAdd(&bar[XB_TMO], 1u); break; } }
  }
  nloc = mine > 0u ? mine : 1u; nx = cnt > 0u ? cnt : 1u;
}
DI void xcd_barrier(const XcdBarrier& b) {
  asm volatile("s_waitcnt vmcnt(0)" ::: "memory");
  __syncthreads();
  if (threadIdx.x == 0) {
    unsigned* bar = b.bar;
    __builtin_amdgcn_s_waitcnt(0);
    unsigned nloc = b.st[0], nx = b.st[1];
    if (nloc == 0u) { xcd_barrier_complete(bar, b.x, nloc, nx); b.st[0] = nloc; b.st[1] = nx; }
    const unsigned old = xb_add(&bar[XB_XSUB(b.x)], 1u);
    const unsigned gen = old / nloc;
    if (old + 1u == (gen + 1u) * nloc) {
      __builtin_amdgcn_fence(__ATOMIC_RELEASE, "agent");
      asm volatile("s_waitcnt vmcnt(0)" ::: "memory");
      const unsigned og = xb_add(&bar[XB_TOP], 1u);
      const unsigned tg = og / nx;
      if (og + 1u == (tg + 1u) * nx) xb_add(&bar[XB_TOPGEN], 1u);
      else XB_SPIN(xb_ld(&bar[XB_TOPGEN]) == tg, bar);
      __builtin_amdgcn_fence(__ATOMIC_ACQUIRE, "agent");
      xb_add(&bar[XB_XGEN(b.x)], 1u);
      asm volatile("s_waitcnt vmcnt(0)" ::: "memory");
    } else {
      XB_SPIN(xb_ld(&bar[XB_XGEN(b.x)]) == gen, bar);
      __builtin_amdgcn_fence(__ATOMIC_ACQUIRE, "agent");
      asm volatile("s_waitcnt vmcnt(0)" ::: "memory");
    }
  }
  __syncthreads();
}

template <int BT, bool RMS, class BRow>
DI void gemm128(const u16* __restrict__ A, int lda, BRow brow, int K, char* lds_, f32x16 (&acc)[2][2], float (&rinv)[2]) {
  static_assert(BT == 1 && !RMS, "only the transposed-B form is used");
  const int tid = ltid() & 255, lane = tid & 63, wave = __builtin_amdgcn_readfirstlane(tid >> 6), r = lane & 31, h = lane >> 5;
  const int wa = wave >> 1, wb = wave & 1;
  LAS char* lds = (LAS char*)lds_;
#pragma unroll
  for (int i = 0; i < 2; ++i)
#pragma unroll
    for (int j = 0; j < 2; ++j)
#pragma unroll
      for (int q = 0; q < 16; ++q) acc[i][j][q] = 0.f;
  rinv[0] = rinv[1] = 1.f;
  const int KT = K / 64;
  unsigned aoff[4];
#pragma unroll
  for (int i = 0; i < 4; ++i) { const int row = (wave * 4 + i) * 8 + (lane >> 3), sl = lane & 7; aoff[i] = (unsigned)(row * lda + ((sl ^ ((row >> 1) & 7)) << 3)) * 2u; }
  auto issue = [&](int kt, int buf) {
#pragma unroll
    for (int i = 0; i < 4; ++i)
      __builtin_amdgcn_global_load_lds((const unsigned*)((const char*)A + aoff[i] + kt * 128), (LAS unsigned*)(lds + buf * 32768 + (wave * 4 + i) * 1024), 16, 0, 0);
#pragma unroll
    for (int i = 0; i < 4; ++i) {
      const int kr = (wave * 4 + i) * 4 + (lane >> 4);
      __builtin_amdgcn_global_load_lds((const unsigned*)(brow(kt * 64 + kr) + (lane & 15) * 8), (LAS unsigned*)(lds + buf * 32768 + 16384 + (wave * 4 + i) * 1024), 16, 0, 0);
    }
  };
  const int y3 = (r >> 1) & 7;
  asm volatile("s_waitcnt vmcnt(0) lgkmcnt(0)" ::: "memory");
  __builtin_amdgcn_s_barrier();
  issue(0, 0);
  for (int kt = 0; kt < KT; ++kt) {
    const int cur = kt & 1;
    asm volatile("s_waitcnt vmcnt(0)" ::: "memory");
    __builtin_amdgcn_s_barrier();
    __builtin_amdgcn_sched_barrier(0);
    if (kt + 1 < KT) issue(kt + 1, cur ^ 1);
    __builtin_amdgcn_sched_barrier(0);
    LAS const char* Ab = lds + cur * 32768 + (wa * 64 + r) * 128;
    LAS const u16* Bb = (LAS const u16*)(lds + cur * 32768 + 16384);
#pragma unroll
    for (int ks = 0; ks < 4; ++ks) {
      bf16x8 af[2], bfr[2];
#pragma unroll
      for (int i = 0; i < 2; ++i) af[i] = *(const LAS bf16x8*)(Ab + i * 32 * 128 + (((2 * ks + h) ^ y3) << 4));
#pragma unroll
      for (int j = 0; j < 2; ++j)
#pragma unroll
        for (int q = 0; q < 8; ++q) bfr[j][q] = (short)Bb[(ks * 16 + 8 * h + q) * 128 + wb * 64 + j * 32 + r];
#pragma unroll
      for (int i = 0; i < 2; ++i)
#pragma unroll
        for (int j = 0; j < 2; ++j) acc[i][j] = MFMA(af[i], bfr[j], acc[i][j]);
    }
  }
}

constexpr int HTB = 128 * 64 * 2;
DI int lds_byte(int r, int c) { int st = (r >> 4) * 2 + (c >> 5), rr = r & 15, cc = c & 31, ob = rr * 64 + cc * 2; return st * 1024 + (ob ^ (((ob >> 9) & 1) << 5)); }
DI void stage_rc(int b, int& R, int& C) { int st = b / 1024, sb = b % 1024, swz = sb ^ (((sb >> 9) & 1) << 5); R = (st >> 1) * 16 + swz / 64; C = (st & 1) * 32 + (swz % 64) / 2; }
DI void gemm256(const u16* __restrict__ A, int lda, const u16* __restrict__ Bt, int ldb, int nt, LAS char* lds, f32x4 (&acc)[2][2][4][2],
                bool pre = false, const u16* __restrict__ An = nullptr, const u16* __restrict__ Bn = nullptr) {
  const int tid = ltid(), wid = __builtin_amdgcn_readfirstlane(tid >> 6), lane = tid & 63, wr = wid >> 2, wc = wid & 3, fr = lane & 15, fq = lane >> 4;
  unsigned voffA[2], voffB[2];
#pragma unroll
  for (int i = 0; i < 2; ++i) { int R, C; stage_rc(tid * 16 + i * 8192, R, C); voffA[i] = (unsigned)(R * lda + C) * 2u; voffB[i] = (unsigned)(R * ldb + C) * 2u; }
  const size_t hstepA = (size_t)128 * lda * 2, hstepB = (size_t)128 * ldb * 2;
  const unsigned ldsw = (unsigned)wid * 1024u;
  const int aoff = lds_byte(wr * 64 + fr, fq * 8), boff = lds_byte(wc * 32 + fr, fq * 8);
  const char* Ab = (const char*)A; const char* Bb = (const char*)Bt;
#define G_SA(b, h) (((b) * 2 + (h)) * HTB)
#define G_SB(b, h) ((4 + (b) * 2 + (h)) * HTB)
#define G_AP(h, kt) (Ab + (size_t)(h) * hstepA + (size_t)(kt) * 128)
#define G_BP(h, kt) (Bb + (size_t)(h) * hstepB + (size_t)(kt) * 128)
#define G_STG(bufoff, gptr, voff_) do { _Pragma("unroll") for (int _i = 0; _i < 2; ++_i) \
    __builtin_amdgcn_global_load_lds((const unsigned*)((gptr) + voff_[_i]), (LAS unsigned*)(lds + (bufoff) + ldsw + _i * 8192), 16, 0, 0); } while (0)
#define G_LDA(dst, b, h) do { _Pragma("unroll") for (int m = 0; m < 4; ++m) _Pragma("unroll") for (int k = 0; k < 2; ++k) dst[m][k] = *(const LAS bf16x8*)(lds + G_SA(b, h) + aoff + m * 2048 + k * 1024); } while (0)
#define G_LDB(dst, b, h) do { _Pragma("unroll") for (int n = 0; n < 2; ++n) _Pragma("unroll") for (int k = 0; k < 2; ++k) dst[n][k] = *(const LAS bf16x8*)(lds + G_SB(b, h) + boff + n * 2048 + k * 1024); } while (0)
#define G_MMA(ai, bj, At_, Bt_) do { __builtin_amdgcn_s_setprio(1); _Pragma("unroll") for (int m = 0; m < 4; ++m) _Pragma("unroll") for (int n = 0; n < 2; ++n) _Pragma("unroll") for (int k = 0; k < 2; ++k) \
    acc[ai][bj][m][n] = __builtin_amdgcn_mfma_f32_16x16x32_bf16(At_[m][k], Bt_[n][k], acc[ai][bj][m][n], 0, 0, 0); __builtin_amdgcn_s_setprio(0); } while (0)
#define G_WV(n) asm volatile("s_waitcnt vmcnt(" #n ")" ::: "memory")
#define G_WL(n) asm volatile("s_waitcnt lgkmcnt(" #n ")" ::: "memory")
#define G_BAR __builtin_amdgcn_s_barrier()
#define G_SCHED __builtin_amdgcn_sched_barrier(0)
  float zer_ = 0.f; asm volatile("" : "+v"(zer_));
#pragma unroll
  for (int a = 0; a < 2; ++a)
#pragma unroll
    for (int b = 0; b < 2; ++b)
#pragma unroll
      for (int m = 0; m < 4; ++m)
#pragma unroll
        for (int n = 0; n < 2; ++n) acc[a][b][m][n] = (f32x4){zer_, zer_, zer_, zer_};
  bf16x8 At[4][2], B0[2][2], B1[2][2];
#define G_ISSUE7() do { G_STG(G_SB(0, 0), G_BP(0, 0), voffB); G_STG(G_SA(0, 0), G_AP(0, 0), voffA); G_STG(G_SB(0, 1), G_BP(1, 0), voffB); G_STG(G_SA(0, 1), G_AP(1, 0), voffA); \
    G_STG(G_SB(1, 0), G_BP(0, 1), voffB); G_STG(G_SA(1, 0), G_AP(0, 1), voffA); G_STG(G_SB(1, 1), G_BP(1, 1), voffB); } while (0)
  if (!pre) { G_WV(0); G_WL(0); G_BAR; G_ISSUE7(); }
  if (wr == 1) G_BAR;
  G_WV(10); G_BAR;
  G_WV(6); G_BAR;
  for (int t = 0; t < nt - 2; t += 2) {
    G_LDB(B0, 0, 0); G_SCHED; G_LDA(At, 0, 0); G_STG(G_SA(1, 1), G_AP(1, t + 1), voffA);
    G_WL(8); G_BAR; G_WL(0); G_MMA(0, 0, At, B0); G_BAR; G_SCHED;
    G_LDB(B1, 0, 1); G_STG(G_SB(0, 0), G_BP(0, t + 2), voffB);
    G_BAR; G_WL(0); G_MMA(0, 1, At, B1); G_BAR;
    G_LDA(At, 0, 1); G_STG(G_SA(0, 0), G_AP(0, t + 2), voffA);
    G_BAR; G_WL(0); G_MMA(1, 0, At, B0); G_BAR; G_SCHED;
    G_STG(G_SB(0, 1), G_BP(1, t + 2), voffB);
    G_WV(6); G_BAR; G_MMA(1, 1, At, B1); G_BAR;
    G_LDB(B0, 1, 0); G_SCHED; G_LDA(At, 1, 0); G_STG(G_SA(0, 1), G_AP(1, t + 2), voffA);
    G_WL(8); G_BAR; G_WL(0); G_MMA(0, 0, At, B0); G_BAR; G_SCHED;
    G_LDB(B1, 1, 1); G_STG(G_SB(1, 0), G_BP(0, t + 3), voffB);
    G_BAR; G_WL(0); G_MMA(0, 1, At, B1); G_BAR;
    G_LDA(At, 1, 1); G_STG(G_SA(1, 0), G_AP(0, t + 3), voffA);
    G_BAR; G_WL(0); G_MMA(1, 0, At, B0); G_BAR; G_SCHED;
    G_STG(G_SB(1, 1), G_BP(1, t + 3), voffB);
    G_WV(6); G_BAR; G_MMA(1, 1, At, B1); G_BAR;
  }
  { G_LDB(B0, 0, 0); G_LDA(At, 0, 0); G_STG(G_SA(1, 1), G_AP(1, nt - 1), voffA);
    G_BAR; G_WL(0); G_MMA(0, 0, At, B0); G_BAR;
    G_LDB(B1, 0, 1); G_BAR; G_WL(0); G_MMA(0, 1, At, B1); G_BAR;
    G_LDA(At, 0, 1); G_WV(4); G_BAR; G_WL(0); G_MMA(1, 0, At, B0); G_MMA(1, 1, At, B1); G_BAR; }
  { G_LDB(B0, 1, 0); G_LDA(At, 1, 0); G_WV(2); G_BAR; G_WL(0); G_MMA(0, 0, At, B0); G_BAR;
    G_LDB(B1, 1, 1); G_WV(0); G_BAR; G_WL(0); G_MMA(0, 1, At, B1); G_BAR;
    G_LDA(At, 1, 1); G_BAR; G_WL(0); G_MMA(1, 0, At, B0); G_MMA(1, 1, At, B1); G_BAR; }
  if (wr == 0) G_BAR;
  if (An != nullptr) { Ab = (const char*)An; Bb = (const char*)Bn; G_ISSUE7(); }
}
#define G_FOREACH(acc, ...) do { \
  _Pragma("unroll") for (int ai = 0; ai < 2; ++ai) _Pragma("unroll") for (int bj = 0; bj < 2; ++bj) \
  _Pragma("unroll") for (int m = 0; m < 4; ++m) _Pragma("unroll") for (int n = 0; n < 2; ++n) { \
    const int f0 = ai * 128 + wr * 64 + m * 16 + fq * 4, tok = bj * 128 + wc * 32 + n * 16 + fr; const f32x4 v = acc[ai][bj][m][n]; __VA_ARGS__ } } while (0)
#define G_LANE_IDS const int tid = ltid(), wid = tid >> 6, lane = tid & 63, wr = wid >> 2, wc = wid & 3, fr = lane & 15, fq = lane >> 4;

DI void rope_block(f32x16& v, int h, int pos, const float2* __restrict__ ropetab) {
  const int rowp = pos >> 6, colp = pos & 63;
#pragma unroll
  for (int g = 0; g < 2; ++g)
#pragma unroll
    for (int i = 0; i < 4; ++i) {
      const int f = 8 * g + 4 * h + i;
      const float2 cs = (f < 8) ? ropetab[rowp * 8 + f] : ropetab[colp * 8 + (f - 8)];
      const float x1 = v[4 * g + i], x2 = v[4 * (g + 2) + i];
      v[4 * g + i] = x1 * cs.x - x2 * cs.y;
      v[4 * (g + 2) + i] = x1 * cs.y + x2 * cs.x;
    }
}

DI void prep_transpose_tile(const float* __restrict__ W, int ldn, int k0, int n0, int nlimit, u16* __restrict__ Wt, int ldk, int ndst0, int kdst0,
                            const float* __restrict__ rowscale, char* lds) {
  float* t = (float*)lds;
  const int tid = ltid() & 255;
  __syncthreads();
#pragma unroll
  for (int it = 0; it < 16; ++it) {
    int i = (tid >> 6) + 4 * it, j = tid & 63;
    float v = 0.f;
    if (n0 + j < nlimit) v = W[(size_t)(k0 + i) * ldn + n0 + j];
    if (rowscale) v *= rowscale[k0 + i];
    t[i * 65 + j] = v;
  }
  __syncthreads();
#pragma unroll
  for (int it = 0; it < 16; ++it) {
    int j = (tid >> 6) + 4 * it, i = tid & 63;
    if (n0 + j < nlimit) Wt[(size_t)(ndst0 + j) * ldk + kdst0 + i] = f2bf(t[i * 65 + j]);
  }
}

DI void phase_prep(const Params& p, char* lds) {
  const int tid = ltid() & 255, G = vgrid(), bid = vbid();
  u16* Win = (u16*)(p.ws + OFF_WIN); u16* Wuq = (u16*)(p.ws + OFF_WUQ); u16* Wukv = (u16*)(p.ws + OFF_WUKV);
  u16* Wo = (u16*)(p.ws + OFF_WO); u16* W1 = (u16*)(p.ws + OFF_W1); u16* W2 = (u16*)(p.ws + OFF_W2);
  {
    const float4* xs = (const float4*)p.x; float4* xd = (float4*)p.out;
    for (size_t i = (size_t)bid * 256 + tid; i < (size_t)NLAT * DM / 4; i += (size_t)G * 256) xd[i] = xs[i];
    const float4* cs = (const float4*)p.ctx; float4* cd = (float4*)(p.ws + OFF_XRC);
    for (size_t i = (size_t)bid * 256 + tid; i < (size_t)NCTX * DM / 4; i += (size_t)G * 256) cd[i] = cs[i];
  }
  for (int e = bid * 256 + tid; e < NLAYER * 1024 * 16; e += G * 256) { const int row = e >> 4, c = e & 15; unsigned z_ = 0u; asm volatile("" : "+v"(z_)); *(uint4*)(Wukv + (size_t)row * 256 + 128 + c * 8) = make_uint4(z_, z_, z_, z_); }
  {
    u16* A1 = (u16*)(p.ws + OFF_A1T); u16* A2 = (u16*)(p.ws + OFF_A2T); u16* A3 = (u16*)(p.ws + OFF_A3T);
    float2* TW = (float2*)(p.ws + OFF_TW); float2* RP = (float2*)(p.ws + OFF_ROPE);
    for (int e = bid * 256 + tid; e < 256 * 256; e += G * 256) {
      int m = e >> 8, k = e & 255; int ro = (m >> 5) & 1, k1 = (m >> 6) * 32 + (m & 31), ri = k >> 7, n1 = k & 127;
      float ang = (float)((n1 * k1) & 127) / 64.f; float c = cospif(ang), s = sinpif(ang);
      float v = (ro == 0) ? (ri == 0 ? c : s) : (ri == 0 ? -s : c);
      A1[e] = f2bf(v);
    }
    for (int e = bid * 256 + tid; e < 128 * 256; e += G * 256) {
      int k2 = e >> 8, k = e & 255; int ri = k >> 7, n2 = k & 127;
      float ang = (float)((n2 * k2) & 127) / 64.f;
      A2[e] = f2bf(ri ? sinpif(ang) : cospif(ang));
    }
    for (int e = bid * 256 + tid; e < 256 * 512; e += G * 256) {
      int kk = e >> 9, k = e & 511; int ri = k >> 8, n = k & 255;
      float ang = (float)((n * kk) & 255) / 128.f;
      A3[e] = f2bf(ri ? sinpif(ang) : cospif(ang));
    }
    for (int e = bid * 256 + tid; e < 16384; e += G * 256) { float ang = (float)e / 8192.f; TW[e] = make_float2(cospif(ang), sinpif(ang)); }
    for (int e = bid * 256 + tid; e < 256 * 8; e += G * 256) {
      int pos = e >> 3, j = e & 7;
      const float invt[8] = {1.f, 0.31622776601683794f, 0.1f, 0.031622776601683794f, 0.01f, 0.0031622776601683794f, 0.001f, 0.00031622776601683794f};
      float inv = j == 0 ? invt[0] : j == 1 ? invt[1] : j == 2 ? invt[2] : j == 3 ? invt[3] : j == 4 ? invt[4] : j == 5 ? invt[5] : j == 6 ? invt[6] : invt[7];
      float angf = (float)pos * inv;
      double tt = (double)angf * 0.15915494309189535;
      tt -= floor(tt);
      float a2 = (float)(2.0 * tt);
      RP[e] = make_float2(cospif(a2), sinpif(a2));
    }
  }
  {
    float* sl = (float*)lds;
    float* part = sl + 3 * 1024;
    float* modo = (float*)(p.ws + OFF_MOD);
    const int lane = tid & 63, wave = tid >> 6;
    for (int it = bid; it < NLAYER * 96; it += G) {
      const int l = it / 96, cgp = it % 96;
      __syncthreads();
      for (int e = tid; e < 3 * 1024; e += 256) {
        int mi = e >> 10, k = e & 1023; float v = mi < 2 ? p.c[mi * 1024 + k] : p.c_ctx[k];
        sl[e] = v * sigmoidf_(v);
      }
      __syncthreads();
      const int j = cgp * 64 + lane;
      const float* wp = p.w_mod + ((size_t)l * 1024 + wave * 256) * 6144 + j;
      float a0 = 0.f, a1 = 0.f, a2 = 0.f;
#pragma unroll 8
      for (int k = 0; k < 256; ++k) {
        float w = wp[(size_t)k * 6144];
        a0 += sl[wave * 256 + k] * w; a1 += sl[1024 + wave * 256 + k] * w; a2 += sl[2048 + wave * 256 + k] * w;
      }
      part[(wave * 3 + 0) * 64 + lane] = a0; part[(wave * 3 + 1) * 64 + lane] = a1; part[(wave * 3 + 2) * 64 + lane] = a2;
      __syncthreads();
      if (tid < 192) {
        int mi = tid >> 6, ln = tid & 63;
        float s = part[(0 * 3 + mi) * 64 + ln] + part[(1 * 3 + mi) * 64 + ln] + part[(2 * 3 + mi) * 64 + ln] + part[(3 * 3 + mi) * 64 + ln];
        int jj = cgp * 64 + ln;
        modo[(size_t)(l * 3 + mi) * 6144 + jj] = s + p.b_mod[l * 6144 + jj];
      }
    }
  }
  {
    constexpr int T_IN = 16 * 15, T_UQ = 4 * 12, T_UKV = 2 * 16, T_O = 8 * 16, T_1 = 16 * 64, T_2 = 64 * 16;
    constexpr int T_L = T_IN + T_UQ + T_UKV + T_O + T_1 + T_2;
    for (int it = bid; it < NLAYER * T_L; it += G) {
      const int l = it / T_L; int t = it % T_L;
      if (t < T_IN) { int kt = t / 15, nt = t % 15;
        prep_transpose_tile(p.w_in + (size_t)l * DM * 1184, 1184, kt * 64, 256 + nt * 64, 1184, Win + (size_t)l * NINP * DM, DM, 512 + nt * 64, kt * 64, nullptr, lds); continue; }
      t -= T_IN;
      if (t < T_UQ) { int kt = t / 12, nt = t % 12;
        prep_transpose_tile(p.w_uq + (size_t)l * 256 * 768, 768, kt * 64, nt * 64, 768, Wuq + (size_t)l * 768 * 256, 256, nt * 64, kt * 64, p.q_norm_g + l * 256, lds); continue; }
      t -= T_UQ;
      if (t < T_UKV) { int kt = t / 16, nt = t % 16;
        prep_transpose_tile(p.w_ukv + (size_t)l * 128 * 1024, 1024, kt * 64, nt * 64, 1024, Wukv + (size_t)l * 1024 * 256, 256, nt * 64, kt * 64, p.kv_norm_g + l * 128, lds); continue; }
      t -= T_UKV;
      if (t < T_O) { int kt = t / 16, nt = t % 16;
        prep_transpose_tile(p.w_o + (size_t)l * DM * DM, DM, 256 + kt * 64, nt * 64, DM, Wo + (size_t)l * DM * DM, DM, nt * 64, 256 + kt * 64, nullptr, lds); continue; }
      t -= T_O;
      if (t < T_1) { int kt = t / 64, nt = t % 64;
        prep_transpose_tile(p.w_mlp1 + (size_t)l * DM * DFF, DFF, kt * 64, nt * 64, DFF, W1 + (size_t)l * DFF * DM, DM, nt * 64, kt * 64, nullptr, lds); continue; }
      t -= T_1;
      { int kt = t / 16, nt = t % 16;
        prep_transpose_tile(p.w_mlp2 + (size_t)l * DFF * DM, DM, kt * 64, nt * 64, DM, W2 + (size_t)l * DM * DFF, DFF, nt * 64, kt * 64, nullptr, lds); }
    }
  }
  {
    float* Ws = (float*)lds;
    float* ct = Ws + 64 * 65;
    float* st = ct + 64;
    for (int it = bid; it < NLAYER * 4 * 16; it += G) {
      const int l = it >> 6, g = (it >> 4) & 3, kt = it & 15;
      __syncthreads();
      if (tid < 64) { float ang = (float)tid / 32.f; ct[tid] = cospif(ang); st[tid] = sinpif(ang); }
#pragma unroll
      for (int i = 0; i < 16; ++i) { int e = tid + 256 * i; int kk = e >> 6, c = e & 63; Ws[kk * 65 + c] = p.w_in[((size_t)l * DM + kt * 64 + kk) * 1184 + g * 64 + c]; }
      __syncthreads();
      const int kk = tid & 63;
      for (int mm = 0; mm < 16; ++mm) {
        const int m = (tid >> 6) + 4 * mm;
        float sr = 0.f, si = 0.f;
        for (int c = 0; c < 64; ++c) { float w = Ws[kk * 65 + c]; int q = (m * c) & 63; sr += w * ct[q]; si -= w * st[q]; }
        u16* dst = Win + (size_t)l * NINP * DM + (size_t)(g * 64 + m) * DM + kt * 64 + kk;
        dst[0] = f2bf(sr); dst[(size_t)256 * DM] = f2bf(si);
      }
    }
  }
  {
    float* Ps = (float*)lds;
    float* Qs = Ps + 32 * 68;
    const int ty = tid >> 4, tx = tid & 15;
    for (int it = bid; it < NLAYER * 2 * 4 * 16; it += G) {
      const int l = it >> 7, wh = (it >> 6) & 1, kt = (it >> 4) & 3, nt = it & 15;
      const float* P = (wh ? p.w_pw2 : p.w_fourier) + (size_t)l * 256 * 256;
      const float* Qm = p.w_o + (size_t)l * DM * DM + (size_t)(wh ? 768 : 0) * DM;
      float acc[4][4];
#pragma unroll
      for (int a = 0; a < 4; ++a)
#pragma unroll
        for (int b = 0; b < 4; ++b) acc[a][b] = 0.f;
      for (int j0 = 0; j0 < 256; j0 += 32) {
        __syncthreads();
#pragma unroll
        for (int i = 0; i < 8; ++i) { int e = tid + 256 * i; int kk = e >> 5, jj = e & 31; Ps[jj * 68 + kk] = P[(size_t)(kt * 64 + kk) * 256 + j0 + jj]; }
#pragma unroll
        for (int i = 0; i < 8; ++i) { int e = tid + 256 * i; int jj = e >> 6, nn = e & 63; Qs[jj * 64 + nn] = Qm[(size_t)(j0 + jj) * DM + nt * 64 + nn]; }
        __syncthreads();
#pragma unroll 8
        for (int jj = 0; jj < 32; ++jj) {
          const float4 a4 = *(const float4*)&Ps[jj * 68 + ty * 4]; const float4 b4 = *(const float4*)&Qs[jj * 64 + tx * 4];
          const float av[4] = {a4.x, a4.y, a4.z, a4.w}, bv[4] = {b4.x, b4.y, b4.z, b4.w};
#pragma unroll
          for (int a = 0; a < 4; ++a)
#pragma unroll
            for (int b = 0; b < 4; ++b) acc[a][b] += av[a] * bv[b];
        }
      }
#pragma unroll
      for (int b = 0; b < 4; ++b) {
        const int n = nt * 64 + tx * 4 + b, k = (wh ? 768 : 0) + kt * 64 + ty * 4;
        *(u32x2*)(Wo + (size_t)l * DM * DM + (size_t)n * DM + k) = pack4(acc[0][b], acc[1][b], acc[2][b], acc[3][b]);
      }
    }
  }
}

DI void phase_norm(const Params& p, int l, int which, char* lds_all) {
  const int tid = ltid(), lane = tid & 63, wave = tid >> 6;
  const float* g = (which ? p.norm2_g : p.norm1_g) + l * DM;
  u16* H = (u16*)(p.ws + OFF_H);
  float* cA = (float*)lds_all; float* cB = cA + 3 * 1024;
  __syncthreads();
  for (int e = tid; e < 3 * 1024; e += 512) {
    const int mi = e >> 10, c = e & 1023;
    cA[e] = g[c] * (1.f + modp(p, l, mi, which ? 4 : 1)[c]);
    cB[e] = modp(p, l, mi, which ? 3 : 0)[c];
  }
  __syncthreads();
  const int RS = gridDim.x * 8;
  const int NR = (which == 1 && l == NLAYER - 1) ? NLAT : NT;
  const int nslab = which ? (l < NLAYER - 1 ? 4 : 0) : (l > 0 ? 8 : 0);
  const float* sgate = which ? modp(p, l, 2, 2) : modp(p, l > 0 ? l - 1 : 0, 2, 5);
  const int nlat_it = (NLAT + RS * 4 - 1) / (RS * 4);
  for (int itn = 0; itn <= nlat_it; ++itn) {
    const bool cpass = itn == nlat_it;
    const int row0 = cpass ? 0 : blockIdx.x * 8 + wave + itn * RS * 4;
    float4 v[4][4]; float ss[4];
    int rows[4];
#pragma unroll
    for (int k = 0; k < 4; ++k) {
      int rr = row0 + k * RS;
      if (!cpass) { if (rr >= NLAT) rr = -1; }
      else { const int c = (blockIdx.x * 2 + (wave >> 2)) + k * (int)gridDim.x * 2; rr = ((wave & 3) == 0 && c < NCTX && NLAT + c < NR) ? NLAT + c : -1; }
      rows[k] = rr;
    }
#pragma unroll
    for (int k = 0; k < 4; ++k) {
      const int row = rows[k];
      if (row >= 0) {
        float* xr = xrow(p, row);
#pragma unroll
        for (int i = 0; i < 4; ++i) v[k][i] = *(const float4*)(xr + i * 256 + lane * 4);
        if (row >= NLAT && nslab > 0) {
          const float* sb = (const float*)(p.ws + OFF_SLAB) + (size_t)(row - NLAT) * DM;
#pragma unroll
          for (int i = 0; i < 4; ++i) {
            const int c = i * 256 + lane * 4;
            float4 a = make_float4(0.f, 0.f, 0.f, 0.f);
            for (int kc = 0; kc < nslab; ++kc) { const float4 t4 = *(const float4*)(sb + (size_t)kc * NCTX * DM + c); a.x += t4.x; a.y += t4.y; a.z += t4.z; a.w += t4.w; }
            const float4 gt = *(const float4*)(sgate + c);
            v[k][i].x += gt.x * a.x; v[k][i].y += gt.y * a.y; v[k][i].z += gt.z * a.z; v[k][i].w += gt.w * a.w;
            *(float4*)(xr + c) = v[k][i];
          }
        }
      } else {
#pragma unroll
        for (int i = 0; i < 4; ++i) v[k][i] = make_float4(0.f, 0.f, 0.f, 0.f);
      }
    }
#pragma unroll
    for (int k = 0; k < 4; ++k) {
      float a = 0.f;
#pragma unroll
      for (int i = 0; i < 4; ++i) a += v[k][i].x * v[k][i].x + v[k][i].y * v[k][i].y + v[k][i].z * v[k][i].z + v[k][i].w * v[k][i].w;
      ss[k] = wave_sum(a);
    }
#pragma unroll
    for (int k = 0; k < 4; ++k) {
      const int row = rows[k];
      if (row >= 0) {
        const float rinv = rsqrtf(ss[k] * (1.f / DM) + EPS);
        const int mi = mod_index(row);
        if (which == 0 && lane < 2) ((float*)(p.ws + OFF_SSQ))[(size_t)row * 2 + lane] = 0.f;
#pragma unroll
        for (int i = 0; i < 4; ++i) {
          const int c = i * 256 + lane * 4;
          const float4 a4 = *(const float4*)(cA + mi * 1024 + c), b4 = *(const float4*)(cB + mi * 1024 + c);
          *(u32x2*)(H + (size_t)row * DM + c) = pack4(v[k][i].x * rinv * a4.x + b4.x, v[k][i].y * rinv * a4.y + b4.y,
                                                     v[k][i].z * rinv * a4.z + b4.z, v[k][i].w * rinv * a4.w + b4.w);
        }
      }
    }
  }
}

DI void phase_win(const Params& p, int l, LAS char* lds) {
  const u16* Win = (const u16*)(p.ws + OFF_WIN) + (size_t)l * NINP * DM;
  const u16* H = (const u16*)(p.ws + OFF_H);
  u16* Z = (u16*)(p.ws + OFF_Z); u16* Kb = (u16*)(p.ws + OFF_K);
  const float2* RP = (const float2*)(p.ws + OFF_ROPE);
  for (int t = blockIdx.x; t < (NT / 256) * 6; t += gridDim.x) {
    const int tt = t / 6, ft = t % 6;
    const int tn = t + gridDim.x; const bool hn = tn < (NT / 256) * 6;
    f32x4 acc[2][2][4][2];
    gemm256(Win + (size_t)ft * 256 * DM, DM, H + (size_t)tt * 256 * DM, DM, DM / 64, lds, acc, t != (int)blockIdx.x,
            hn ? Win + (size_t)(tn % 6) * 256 * DM : nullptr, hn ? H + (size_t)(tn / 6) * 256 * DM : nullptr);
    G_LANE_IDS
    G_FOREACH(acc, {
      const int F = ft * 256 + f0, T = tt * 256 + tok;
      if (F < 896 || (F >= 928 && F < ZW)) *(u32x2*)(Z + (size_t)T * ZW + F) = pack4(v[0], v[1], v[2], v[3]);
    });
    if (ft == 2 || ft == 3) {
      float* ssq = (float*)(p.ws + OFF_SSQ);
#pragma unroll
      for (int bj = 0; bj < 2; ++bj)
#pragma unroll
        for (int n = 0; n < 2; ++n) {
          float a = 0.f;
#pragma unroll
          for (int ai = 0; ai < 2; ++ai)
#pragma unroll
            for (int m = 0; m < 4; ++m) {
              if (ft == 3 && ai == 1) continue;
              const f32x4 v = acc[ai][bj][m][n];
              a += v[0] * v[0] + v[1] * v[1] + v[2] * v[2] + v[3] * v[3];
            }
          a += shx(a, 16); a += shx(a, 32);
          if (fq == 0) atomicAdd(ssq + (size_t)(tt * 256 + bj * 128 + wc * 32 + n * 16 + fr) * 2 + (ft - 2), a);
        }
    }
    if (ft == 3 && wr == 0) {
#pragma unroll
      for (int bj = 0; bj < 2; ++bj)
#pragma unroll
        for (int n = 0; n < 2; ++n) {
          const int T = tt * 256 + bj * 128 + wc * 32 + n * 16 + fr;
          int b, key, pos; bool lat; tok_info(T, b, key, lat, pos);
          f32x4 x1 = acc[1][bj][0][n], x2 = acc[1][bj][1][n];
          if (lat) {
            const int rowp = pos >> 6, colp = pos & 63;
#pragma unroll
            for (int j = 0; j < 4; ++j) {
              const int i = fq * 4 + j;
              const float2 cs = (i < 8) ? RP[rowp * 8 + i] : RP[colp * 8 + (i - 8)];
              const float a = x1[j], c = x2[j];
              x1[j] = a * cs.x - c * cs.y; x2[j] = a * cs.y + c * cs.x;
            }
          }
          const u32x2 p1 = pack4(x1[0], x1[1], x1[2], x1[3]), p2 = pack4(x2[0], x2[1], x2[2], x2[3]);
#pragma unroll
          for (int hh = 0; hh < NH; ++hh) {
            u16* kd = Kb + ((size_t)(b * NH + hh) * NKEYS + key) * 96 + 64 + fq * 4;
            *(u32x2*)kd = p1; *(u32x2*)(kd + 16) = p2;
          }
        }
    }
  }
}

DI void mid_up256(const Params& p, int l, int t, int tn, LAS char* lds) {
  const u16* Zb = (const u16*)(p.ws + OFF_Z);
  const float* ssq = (const float*)(p.ws + OFF_SSQ);
  f32x4 acc[2][2][4][2];
  const bool isq = t < (NT / 256) * 3;
  const int u = isq ? t : t - (NT / 256) * 3;
  const int tt = isq ? u / 3 : u / 4, ft = isq ? u % 3 : u % 4;
  auto ptrs = [&](int ti, const u16*& a_, const u16*& b_) {
    const bool q_ = ti < (NT / 256) * 3; const int u_ = q_ ? ti : ti - (NT / 256) * 3; const int tt_ = q_ ? u_ / 3 : u_ / 4, ft_ = q_ ? u_ % 3 : u_ % 4;
    a_ = (q_ ? (const u16*)(p.ws + OFF_WUQ) + (size_t)l * 768 * 256 : (const u16*)(p.ws + OFF_WUKV) + (size_t)l * 1024 * 256) + (size_t)ft_ * 256 * 256;
    b_ = Zb + (size_t)tt_ * 256 * ZW + (q_ ? 512 : 768); };
  const u16* a0; const u16* b0; ptrs(t, a0, b0);
  const u16* a1 = nullptr; const u16* b1 = nullptr; if (tn >= 0) ptrs(tn, a1, b1);
  gemm256(a0, 256, b0, ZW, 4, lds, acc, t != (int)blockIdx.x, a1, b1);
  G_LANE_IDS
  if (isq) {
    u16* Q = (u16*)(p.ws + OFF_Q);
    const float2* RP = (const float2*)(p.ws + OFF_ROPE);
#pragma unroll
    for (int bj = 0; bj < 2; ++bj)
#pragma unroll
      for (int n = 0; n < 2; ++n) {
        const int T = tt * 256 + bj * 128 + wc * 32 + n * 16 + fr;
        const float sc = rsqrtf(ssq[(size_t)T * 2] * (1.f / 256.f) + EPS) * QSCALE;
        const bool lat = T < NLAT;
        const int pos = T & (SEQ - 1), rowp = pos >> 6, colp = pos & 63;
#pragma unroll
        for (int ai = 0; ai < 2; ++ai)
#pragma unroll
          for (int mp = 0; mp < 4; mp += 2) {
            f32x4 x1 = acc[ai][bj][mp][n] * sc, x2 = acc[ai][bj][mp + 1][n] * sc;
            const int b16 = ft * 16 + ai * 8 + wr * 4 + mp;
            if ((b16 % 6) == 4 && lat) {
#pragma unroll
              for (int j = 0; j < 4; ++j) {
                const int i = fq * 4 + j;
                const float2 cs = (i < 8) ? RP[rowp * 8 + i] : RP[colp * 8 + (i - 8)];
                const float a = x1[j], c = x2[j];
                x1[j] = a * cs.x - c * cs.y; x2[j] = a * cs.y + c * cs.x;
              }
            }
            u16* qd = Q + (size_t)T * 768 + b16 * 16 + fq * 4;
            *(u32x2*)qd = pack4(x1[0], x1[1], x1[2], x1[3]);
            *(u32x2*)(qd + 16) = pack4(x2[0], x2[1], x2[2], x2[3]);
          }
      }
  } else {
    u16* Kb = (u16*)(p.ws + OFF_K); u16* Vt = (u16*)(p.ws + OFF_VT);
#pragma unroll
    for (int bj = 0; bj < 2; ++bj)
#pragma unroll
      for (int n = 0; n < 2; ++n) {
        const int T = tt * 256 + bj * 128 + wc * 32 + n * 16 + fr;
        const float sc = rsqrtf(ssq[(size_t)T * 2 + 1] * (1.f / 128.f) + EPS);
        int b, key, pos; bool lat; tok_info(T, b, key, lat, pos);
        const int kp = vpos(key);
#pragma unroll
        for (int ai = 0; ai < 2; ++ai) {
          const int hh = ft * 2 + ai;
#pragma unroll
          for (int m = 0; m < 4; ++m) {
            const f32x4 v = acc[ai][bj][m][n] * sc;
            const int within = wr * 64 + m * 16 + fq * 4;
            if (wr == 0) {
              *(u32x2*)(Kb + ((size_t)(b * NH + hh) * NKEYS + key) * 96 + within) = pack4(v[0], v[1], v[2], v[3]);
            } else {
              u16* vd = Vt + ((size_t)(b * NH + hh) * 64 + (within - 64)) * NKEYS + kp;
              vd[0] = f2bf(v[0]); vd[NKEYS] = f2bf(v[1]); vd[2 * NKEYS] = f2bf(v[2]); vd[3 * NKEYS] = f2bf(v[3]);
            }
          }
        }
      }
  }
}
DI void mid_conv(const Params& p, int l, int it, char* lds) {
  const int tid = ltid() & 255, lane = tid & 63, wave = tid >> 6;
  const int row0 = it * 32;
  int seqbase, n0, N;
  if (row0 < NLAT) { seqbase = row0 & ~(SEQ - 1); n0 = row0 & (SEQ - 1); N = SEQ; }
  else { int rr = row0 - NLAT; seqbase = NLAT + (rr & ~255); n0 = rr & 255; N = CTXL; }
  const u16* Z = (const u16*)(p.ws + OFF_Z);
  u16* CAT = (u16*)(p.ws + OFF_CAT);
  float* us = (float*)lds;
  const int c = tid;
  __syncthreads();
#pragma unroll 1
  for (int r0 = 0; r0 < 64; r0 += 8) {
    u16 av[8], gv[8];
#pragma unroll
    for (int k = 0; k < 8; ++k) {
      int n = n0 - 15 + r0 + k; n = n < 0 ? 0 : (n >= N ? N - 1 : n);
      const u16* zr = Z + (size_t)(seqbase + n) * ZW;
      av[k] = zr[928 + c]; gv[k] = zr[1184 + c];
    }
    __builtin_amdgcn_sched_barrier(0);
#pragma unroll
    for (int k = 0; k < 8; ++k) {
      const int rr = r0 + k, n = n0 - 15 + rr;
      const float a = bf2f(av[k]), g = bf2f(gv[k]);
      const float u = (n >= 0 && n < N) ? a * sigmoidf_(g) : 0.f;
      if (rr < 62) us[rr * 256 + c] = u;
    }
  }
  float w[31];
#pragma unroll
  for (int j = 0; j < 31; ++j) w[j] = p.w_dw[((size_t)l * 31 + j) * 256 + c];
  const float bias = p.b_dw[l * 256 + c];
#pragma unroll 1
  for (int t0 = 0; t0 < 32; t0 += 8) {
    float acc[8];
#pragma unroll
    for (int o = 0; o < 8; ++o) acc[o] = bias;
#pragma unroll
    for (int rr = 0; rr < 38; ++rr) {
      const float u = us[(t0 + rr) * 256 + c];
#pragma unroll
      for (int o = 0; o < 8; ++o) { const int j = rr - o; if (j >= 0 && j < 31) acc[o] += w[j] * u; }
    }
#pragma unroll
    for (int o = 0; o < 8; ++o) us[(t0 + o) * 256 + c] = acc[o];
  }
  __syncthreads();
  const float4 lg = *(const float4*)(p.conv_ln_g + l * 256 + lane * 4), lb = *(const float4*)(p.conv_ln_b + l * 256 + lane * 4);
#pragma unroll
  for (int tt = 0; tt < 8; ++tt) {
    const int t = wave * 8 + tt;
    const float4 x = *(const float4*)(us + t * 256 + lane * 4);
    const float mu = wave_sum(x.x + x.y + x.z + x.w) * (1.f / 256.f);
    const float d0 = x.x - mu, d1 = x.y - mu, d2 = x.z - mu, d3 = x.w - mu;
    const float var = wave_sum(d0 * d0 + d1 * d1 + d2 * d2 + d3 * d3) * (1.f / 256.f);
    const float ri = rsqrtf(var + EPS);
    float y0 = d0 * ri * lg.x + lb.x, y1 = d1 * ri * lg.y + lb.y, y2 = d2 * ri * lg.z + lb.z, y3 = d3 * ri * lg.w + lb.w;
    y0 *= sigmoidf_(y0); y1 *= sigmoidf_(y1); y2 *= sigmoidf_(y2); y3 *= sigmoidf_(y3);
    *(u32x2*)(CAT + (size_t)(row0 + t) * DM + 768 + lane * 4) = pack4(y0, y1, y2, y3);
  }
}
DI void mid_fft1(const Params& p, int t, char* lds) {
  const int tid = ltid() & 255, lane = tid & 63, wave = tid >> 6, r = lane & 31, h = lane >> 5, wa = wave >> 1, wb = wave & 1;
  const int ntile = t & 1, mt = (t >> 1) & 1, n2 = (t >> 2) & 127, b = t >> 9;
  const u16* A1 = (const u16*)(p.ws + OFF_A1T) + (size_t)mt * 128 * 256;
  const u16* Z = (const u16*)(p.ws + OFF_Z);
  u16* Y = (u16*)(p.ws + OFF_Y);
  const float2* TW = (const float2*)(p.ws + OFF_TW);
  f32x16 acc[2][2]; float rinv[2];
  gemm128<1, false>(A1, 256, [&](int k) { return Z + (size_t)(b * SEQ + 128 * (k & 127) + n2) * ZW + (k >> 7) * 256 + ntile * 128; }, 256, lds, acc, rinv);
#pragma unroll
  for (int j = 0; j < 2; ++j) {
    const int ch = ntile * 128 + wb * 64 + j * 32 + r;
#pragma unroll
    for (int q = 0; q < 16; ++q) {
      const int k1 = mt * 64 + wa * 32 + crow(q, h);
      const float2 tw = TW[n2 * k1];
      const float yr = acc[0][j][q], yi = acc[1][j][q];
      u16* dst = Y + ((size_t)(b * 128 + k1) * 128 + n2) * 512 + ch;
      dst[0] = f2bf(yr * tw.x + yi * tw.y);
      dst[256] = f2bf(yi * tw.x - yr * tw.y);
    }
  }
}
DI void mid_ctxdft(const Params& p, int t, char* lds) {
  const int tid = ltid() & 255, lane = tid & 63, wave = tid >> 6, r = lane & 31, h = lane >> 5, wa = wave >> 1, wb = wave & 1;
  const int ntile = t & 1, mt = (t >> 1) & 1, b = t >> 2;
  const u16* A3 = (const u16*)(p.ws + OFF_A3T) + (size_t)mt * 128 * 512;
  const u16* Z = (const u16*)(p.ws + OFF_Z);
  u16* CAT = (u16*)(p.ws + OFF_CAT);
  f32x16 acc[2][2]; float rinv[2];
  gemm128<1, false>(A3, 512, [&](int k) { return Z + (size_t)(NLAT + b * 256 + (k & 255)) * ZW + (k >> 8) * 256 + ntile * 128; }, 512, lds, acc, rinv);
#pragma unroll
  for (int i = 0; i < 2; ++i)
#pragma unroll
    for (int j = 0; j < 2; ++j) {
      const int ch = ntile * 128 + wb * 64 + j * 32 + r;
#pragma unroll
      for (int q = 0; q < 16; ++q) {
        const int kk = mt * 128 + wa * 64 + i * 32 + crow(q, h);
        CAT[(size_t)(NLAT + b * 256 + kk) * DM + ch] = f2bf(acc[i][j][q] * (1.f / 128.f));
      }
    }
}
constexpr int N_UP256 = (NT / 256) * 7, N_CONV = NT / 32, N_FFT1 = 2 * 128 * 4, N_CDFT = 8;
DI void phase_mid(const Params& p, int l, char* lds, LAS char* lds3) {
  for (int it = blockIdx.x; it < N_UP256; it += gridDim.x) mid_up256(p, l, it, (it + (int)gridDim.x < N_UP256) ? it + (int)gridDim.x : -1, lds3);
  __syncthreads();
  const int G2 = vgrid(), rot = ((N_UP256 % (int)gridDim.x) * 2) % G2;
  for (int it = (vbid() - rot + G2) % G2; it < N_CONV + N_FFT1 + N_CDFT; it += G2) {
    int t = it;
    if (t < N_CDFT) { mid_ctxdft(p, t, lds); continue; }
    t -= N_CDFT;
    if (t < N_FFT1) { mid_fft1(p, t, lds); continue; }
    t -= N_FFT1;
    mid_conv(p, l, t, lds);
  }
}

DI void attn_fft2(const Params& p, int t, char* lds) {
  const int tid = ltid() & 255, lane = tid & 63, wave = tid >> 6, r = lane & 31, h = lane >> 5, wa = wave >> 1, wb = wave & 1;
  const int ntile = t & 1, k1 = (t >> 1) & 127, b = t >> 8;
  const u16* A2 = (const u16*)(p.ws + OFF_A2T);
  const u16* Y = (const u16*)(p.ws + OFF_Y);
  u16* CAT = (u16*)(p.ws + OFF_CAT);
  f32x16 acc[2][2]; float rinv[2];
  gemm128<1, false>(A2, 256, [&](int k) { return Y + ((size_t)(b * 128 + k1) * 128 + (k & 127)) * 512 + (k >> 7) * 256 + ntile * 128; }, 256, lds, acc, rinv);
#pragma unroll
  for (int i = 0; i < 2; ++i)
#pragma unroll
    for (int j = 0; j < 2; ++j) {
      const int ch = ntile * 128 + wb * 64 + j * 32 + r;
#pragma unroll
      for (int q = 0; q < 16; ++q) {
        const int k2 = wa * 64 + i * 32 + crow(q, h);
        CAT[(size_t)(b * SEQ + k1 + 128 * k2) * DM + ch] = f2bf(acc[i][j][q] * (1.f / 1024.f));
      }
    }
}
constexpr int AST = 40960;
DI void attn8(const u16* __restrict__ Qp, const u16* __restrict__ Kp, const u16* __restrict__ Vp, int nkeys, u16* __restrict__ Op, LAS char* lds) {
  const int tid = ltid(), wid = __builtin_amdgcn_readfirstlane(tid >> 6), lane = tid & 63, r = lane & 31, h = lane >> 5;
  bf16x8 qf[6];
  {
    const u16* qrow = Qp + (size_t)(wid * 32 + r) * 768 + 8 * h;
#pragma unroll
    for (int s = 0; s < 6; ++s) qf[s] = *(const bf16x8*)(qrow + 16 * s);
  }
  const char* src[5];
#pragma unroll
  for (int i = 0; i < 5; ++i) {
    const int pce = wid * 5 + i;
    if (pce < 24) {
      const int byte = pce * 1024 + lane * 16, row = byte / 192, sl = (byte % 192) >> 4;
      src[i] = (const char*)Kp + row * 192 + ((sl ^ ((row >> 2) & 3)) << 4);
    } else {
      const int hv = (pce - 24) >> 3, byte = ((pce - 24) & 7) * 1024 + lane * 16, d = byte >> 7, sl = (byte & 127) >> 4;
      src[i] = (const char*)Vp + (size_t)d * (NKEYS * 2) + hv * 128 + ((sl ^ ((d >> 1) & 7)) << 4);
    }
  }
  auto issue = [&](int slot) {
#pragma unroll
    for (int i = 0; i < 5; ++i) {
      const int pce = wid * 5 + i;
      __builtin_amdgcn_global_load_lds((const unsigned*)src[i], (LAS unsigned*)(lds + slot * AST + pce * 1024), 16, 0, 0);
      src[i] += (pce < 24) ? 128 * 192 : 256;
    }
  };
  const int x2 = (r >> 2) & 3, y3 = (r >> 1) & 7;
  const int ko_e = r * 192 + ((h ^ x2) << 4), ko_o = r * 192 + (((2 + h) ^ x2) << 4);
  int vo[4];
#pragma unroll
  for (int sl = 0; sl < 4; ++sl) vo[sl] = r * 128 + (((2 * sl + h) ^ y3) << 4);
  f32x16 o0, o1;
#pragma unroll
  for (int q = 0; q < 16; ++q) { o0[q] = 0.f; o1[q] = 0.f; }
  float m_run = 0.f, l_run = 0.f;
  f32x16 negm;
#pragma unroll
  for (int q = 0; q < 16; ++q) negm[q] = 0.f;
  const int NST = nkeys / 128;
  asm volatile("s_waitcnt vmcnt(0) lgkmcnt(0)" ::: "memory");
  __builtin_amdgcn_s_barrier();
  issue(0);
  if (NST > 1) issue(1);
  int slot = 0;
  for (int t = 0; t < NST; ++t) {
    if (t + 1 < NST) asm volatile("s_waitcnt vmcnt(5)" ::: "memory"); else asm volatile("s_waitcnt vmcnt(0)" ::: "memory");
    __builtin_amdgcn_s_barrier();
    __builtin_amdgcn_sched_barrier(0);
    if (t + 2 < NST) { int s2 = slot + 2; if (s2 >= 3) s2 -= 3; issue(s2); }
    __builtin_amdgcn_sched_barrier(0);
    LAS const char* Sb = lds + slot * AST;
#pragma unroll
    for (int hv = 0; hv < 2; ++hv) {
      f32x16 s0, s1;
      bf16x8 ka0[6], ka1[6];
#pragma unroll
      for (int s = 0; s < 6; ++s) {
        const int ko = (s & 1) ? ko_o : ko_e;
        ka0[s] = *(const LAS bf16x8*)(Sb + (hv * 64) * 192 + (s >> 1) * 64 + ko);
        ka1[s] = *(const LAS bf16x8*)(Sb + (hv * 64 + 32) * 192 + (s >> 1) * 64 + ko);
      }
      __builtin_amdgcn_sched_barrier(0);
      s0 = MFMA(ka0[0], qf[0], negm); s1 = MFMA(ka1[0], qf[0], negm);
#pragma unroll
      for (int s = 1; s < 6; ++s) { s0 = MFMA(ka0[s], qf[s], s0); s1 = MFMA(ka1[s], qf[s], s1); }
      LAS const char* Vb = Sb + 24576 + hv * 8192;
      bf16x8 vf0[4], vf1[4];
#pragma unroll
      for (int sl = 0; sl < 4; ++sl) { vf0[sl] = *(const LAS bf16x8*)(Vb + vo[sl]); vf1[sl] = *(const LAS bf16x8*)(Vb + 32 * 128 + vo[sl]); }
      __builtin_amdgcn_sched_barrier(0);
      float mt_ = s0[0];
#pragma unroll
      for (int q = 1; q < 16; ++q) mt_ = fmaxf(mt_, s0[q]);
#pragma unroll
      for (int q = 0; q < 16; ++q) mt_ = fmaxf(mt_, s1[q]);
      mt_ = swap_max(mt_);
      const bool first = (hv == 0) && (t == 0);
      if (first || !__all(mt_ <= 8.f)) {
        const float delta = first ? mt_ : fmaxf(mt_, 0.f);
        const float alpha = first ? 1.f : __builtin_amdgcn_exp2f(-delta);
        m_run += delta;
        l_run *= alpha;
#pragma unroll
        for (int q = 0; q < 16; ++q) { o0[q] *= alpha; o1[q] *= alpha; s0[q] -= delta; s1[q] -= delta; negm[q] = -m_run; }
      }
      float ps = 0.f;
#pragma unroll
      for (int q = 0; q < 16; ++q) { s0[q] = __builtin_amdgcn_exp2f(s0[q]); ps += s0[q]; }
#pragma unroll
      for (int q = 0; q < 16; ++q) { s1[q] = __builtin_amdgcn_exp2f(s1[q]); ps += s1[q]; }
      l_run += ps;
      bf16x8 pf[4];
      {
        u32x4 w;
        w[0] = cvtpk(s0[0], s0[1]); w[1] = cvtpk(s0[2], s0[3]); w[2] = cvtpk(s0[4], s0[5]); w[3] = cvtpk(s0[6], s0[7]); pf[0] = __builtin_bit_cast(bf16x8, w);
        w[0] = cvtpk(s0[8], s0[9]); w[1] = cvtpk(s0[10], s0[11]); w[2] = cvtpk(s0[12], s0[13]); w[3] = cvtpk(s0[14], s0[15]); pf[1] = __builtin_bit_cast(bf16x8, w);
        w[0] = cvtpk(s1[0], s1[1]); w[1] = cvtpk(s1[2], s1[3]); w[2] = cvtpk(s1[4], s1[5]); w[3] = cvtpk(s1[6], s1[7]); pf[2] = __builtin_bit_cast(bf16x8, w);
        w[0] = cvtpk(s1[8], s1[9]); w[1] = cvtpk(s1[10], s1[11]); w[2] = cvtpk(s1[12], s1[13]); w[3] = cvtpk(s1[14], s1[15]); pf[3] = __builtin_bit_cast(bf16x8, w);
      }
#pragma unroll
      for (int sl = 0; sl < 4; ++sl) { o0 = MFMA(vf0[sl], pf[sl], o0); o1 = MFMA(vf1[sl], pf[sl], o1); }
    }
    slot = (slot == 2) ? 0 : slot + 1;
  }
  const float linv = 1.f / swap_sum(l_run);
  u16* orow = Op + (size_t)(wid * 32 + r) * DM;
#pragma unroll
  for (int g = 0; g < 4; ++g) {
    *(u32x2*)(orow + 8 * g + 4 * h) = pack4(o0[4 * g] * linv, o0[4 * g + 1] * linv, o0[4 * g + 2] * linv, o0[4 * g + 3] * linv);
    *(u32x2*)(orow + 32 + 8 * g + 4 * h) = pack4(o1[4 * g] * linv, o1[4 * g + 1] * linv, o1[4 * g + 2] * linv, o1[4 * g + 3] * linv);
  }
}
constexpr int N_FFT2 = 2 * 128 * 2, N_ACTX = 2 * NH, N_ALAT = 2 * NH * 64;
DI void phase_attn(const Params& p, char* lds, LAS char* lds3) {
  const u16* Q = (const u16*)(p.ws + OFF_Q); const u16* Kb = (const u16*)(p.ws + OFF_K); const u16* Vt = (const u16*)(p.ws + OFF_VT);
  u16* CAT = (u16*)(p.ws + OFF_CAT);
  for (int it = vbid(); it < N_FFT2; it += vgrid()) attn_fft2(p, it, lds);
  __syncthreads();
  for (int it = blockIdx.x; it < N_ACTX + N_ALAT; it += gridDim.x) {
    int t = it;
    if (t < N_ACTX) {
      const int hh = t & 7, b = t >> 3;
      const int row0 = NLAT + b * 256;
      attn8(Q + (size_t)row0 * 768 + hh * 96, Kb + (size_t)(b * NH + hh) * NKEYS * 96, Vt + (size_t)(b * NH + hh) * 64 * NKEYS, CTXL,
            CAT + (size_t)row0 * DM + 256 + hh * 64, lds3);
      continue;
    }
    t -= N_ACTX;
    {
      const int qt = t & 63, hh = (t >> 6) & 7, b = t >> 9;
      const int row0 = b * SEQ + qt * 256;
      attn8(Q + (size_t)row0 * 768 + hh * 96, Kb + (size_t)(b * NH + hh) * NKEYS * 96, Vt + (size_t)(b * NH + hh) * 64 * NKEYS, NKEYS,
            CAT + (size_t)row0 * DM + 256 + hh * 64, lds3);
    }
  }
}

template <int KFULL, int KS>
DI void resid_gemm_phase(const Params& p, int l, const u16* __restrict__ W, const u16* __restrict__ X, int gate_chunk, LAS char* lds) {
  constexpr int NWHOLE = (NLAT / 256) * 4, KC = KFULL / KS;
  const int nitems = NWHOLE + ((l == NLAYER - 1) ? 0 : 8 * KS);
  float* slab = (float*)(p.ws + OFF_SLAB);
  for (int t = blockIdx.x; t < nitems; t += gridDim.x) {
    f32x4 acc[2][2][4][2];
    const bool split = t >= NWHOLE;
    auto tile_of = [&](int ti, int& tile_, int& kc_) {
      const int u_ = ti - NWHOLE, bx = ti & 7, bs = (ti & 255) >> 3, rnd = ti >> 8;
      tile_ = ti >= NWHOLE ? NWHOLE + u_ / KS : (rnd * 64 + bx * 8 + (bs >> 2)) * 4 + (bs & 3); kc_ = ti >= NWHOLE ? u_ % KS : 0; };
    int tile, kc; tile_of(t, tile, kc);
    const int tt = tile / 4, ft = tile % 4;
    const int tn = t + gridDim.x; const bool hn = tn < nitems;
    int tile_n = 0, kc_n = 0; if (hn) tile_of(tn, tile_n, kc_n);
    gemm256(W + (size_t)ft * 256 * KFULL + kc * KC, KFULL, X + (size_t)tt * 256 * KFULL + kc * KC, KFULL, split ? KC / 64 : KFULL / 64, lds, acc, t != (int)blockIdx.x,
            hn ? W + (size_t)(tile_n % 4) * 256 * KFULL + kc_n * KC : nullptr, hn ? X + (size_t)(tile_n / 4) * 256 * KFULL + kc_n * KC : nullptr);
    G_LANE_IDS
    if (split) {
      float* sb = slab + (size_t)kc * NCTX * DM;
      G_FOREACH(acc, {
        const int F = ft * 256 + f0, T = tt * 256 + tok - NLAT;
        *(float4*)(sb + (size_t)T * DM + F) = make_float4(v[0], v[1], v[2], v[3]);
      });
    } else {
      const float* gate = modp(p, l, mod_index(tt * 256), gate_chunk);
      G_FOREACH(acc, {
        const int F = ft * 256 + f0, T = tt * 256 + tok;
        float* xr = xrow(p, T) + F;
        const float4 gt = *(const float4*)(gate + F);
        float4 xv = *(float4*)xr;
        xv.x += gt.x * v[0]; xv.y += gt.y * v[1]; xv.z += gt.z * v[2]; xv.w += gt.w * v[3];
        *(float4*)xr = xv;
      });
    }
  }
}
constexpr int KS_WO = 4, KS_M2 = 8;
DI void phase_wo(const Params& p, int l, LAS char* lds) {
  resid_gemm_phase<DM, KS_WO>(p, l, (const u16*)(p.ws + OFF_WO) + (size_t)l * DM * DM, (const u16*)(p.ws + OFF_CAT), 2, lds);
}
DI void phase_mlp1(const Params& p, int l, LAS char* lds) {
  const u16* W1 = (const u16*)(p.ws + OFF_W1) + (size_t)l * DFF * DM;
  const u16* H = (const u16*)(p.ws + OFF_H);
  u16* A1 = (u16*)(p.ws + OFF_A1);
  const int ntt = (l == NLAYER - 1) ? NLAT / 256 : NT / 256;
  for (int t = blockIdx.x; t < ntt * 16; t += gridDim.x) {
    const int tt = t / 16, ft = t % 16;
    const int tn = t + gridDim.x; const bool hn = tn < ntt * 16;
    f32x4 acc[2][2][4][2];
    gemm256(W1 + (size_t)ft * 256 * DM, DM, H + (size_t)tt * 256 * DM, DM, DM / 64, lds, acc, t != (int)blockIdx.x,
            hn ? W1 + (size_t)(tn % 16) * 256 * DM : nullptr, hn ? H + (size_t)(tn / 16) * 256 * DM : nullptr);
    G_LANE_IDS
    G_FOREACH(acc, {
      const int F = ft * 256 + f0, T = tt * 256 + tok;
      const float a = fmaxf(v[0], 0.f), b = fmaxf(v[1], 0.f), c = fmaxf(v[2], 0.f), d = fmaxf(v[3], 0.f);
      *(u32x2*)(A1 + (size_t)T * DFF + F) = pack4(a * a, b * b, c * c, d * d);
    });
  }
}
DI void phase_mlp2(const Params& p, int l, LAS char* lds) {
  resid_gemm_phase<DFF, KS_M2>(p, l, (const u16*)(p.ws + OFF_W2) + (size_t)l * DM * DFF, (const u16*)(p.ws + OFF_A1), 5, lds);
}
DI void phase_final(const Params& p) {
  const int tid = ltid(), lane = tid & 63, wave = tid >> 6;
  const int RS = gridDim.x * 8;
  float4 g4[4];
#pragma unroll
  for (int i = 0; i < 4; ++i) g4[i] = *(const float4*)(p.final_norm_g + i * 256 + lane * 4);
  for (int row0 = blockIdx.x * 8 + wave; row0 < NLAT; row0 += RS * 4) {
    float4 v[4][4]; float ss[4];
#pragma unroll
    for (int k = 0; k < 4; ++k) {
      const int row = row0 + k * RS;
      const float* xr = p.out + (size_t)(row < NLAT ? row : row0) * DM;
#pragma unroll
      for (int i = 0; i < 4; ++i) v[k][i] = *(const float4*)(xr + i * 256 + lane * 4);
    }
#pragma unroll
    for (int k = 0; k < 4; ++k) {
      float a = 0.f;
#pragma unroll
      for (int i = 0; i < 4; ++i) a += v[k][i].x * v[k][i].x + v[k][i].y * v[k][i].y + v[k][i].z * v[k][i].z + v[k][i].w * v[k][i].w;
      ss[k] = wave_sum(a);
    }
#pragma unroll
    for (int k = 0; k < 4; ++k) {
      const int row = row0 + k * RS;
      if (row < NLAT) {
        const float rinv = rsqrtf(ss[k] * (1.f / DM) + EPS);
        float* xr = p.out + (size_t)row * DM;
#pragma unroll
        for (int i = 0; i < 4; ++i)
          *(float4*)(xr + i * 256 + lane * 4) = make_float4(v[k][i].x * rinv * g4[i].x, v[k][i].y * rinv * g4[i].y, v[k][i].z * rinv * g4[i].z, v[k][i].w * rinv * g4[i].w);
      }
    }
  }
}

constexpr int N_PHASES = 2 + 8 * NLAYER;
DI void run_phase(const Params& p, int ph, char* lds_all) {
#define HLDS (lds_all + (ltid() >> 8) * 73728)
  LAS char* lds3 = (LAS char*)lds_all;
  if (ph == 0) { phase_prep(p, HLDS); return; }
  if (ph == N_PHASES - 1) { phase_final(p); return; }
  const int l = (ph - 1) >> 3, s = (ph - 1) & 7;
  switch (s) {
    case 0: phase_norm(p, l, 0, lds_all); break;
    case 1: phase_win(p, l, lds3); break;
    case 2: phase_mid(p, l, HLDS, lds3); break;
    case 3: phase_attn(p, HLDS, lds3); break;
    case 4: phase_wo(p, l, lds3); break;
    case 5: phase_norm(p, l, 1, lds_all); break;
    case 6: phase_mlp1(p, l, lds3); break;
    default: phase_mlp2(p, l, lds3); break;
  }
}

extern __shared__ __attribute__((aligned(16))) char dyn_lds[];

#ifndef DIAG
#define DIAG 0
#endif
#ifndef DIAG_A
#define DIAG_A 0x008
#endif
#ifndef DIAG_B
#define DIAG_B 0x0C0
#endif
__global__ void __launch_bounds__(512, 2) mega_kernel(Params p) {
  cg::grid_group grid = cg::this_grid();
  volatile LAS unsigned* st = (volatile LAS unsigned*)((LAS char*)dyn_lds + LDS_PHASE);
  if (threadIdx.x == 0) { st[0] = 0u; st[1] = 0u; st[2] = 0u; st[3] = 0u; }
  __syncthreads();
  (void)xcd_barrier_post((unsigned*)(p.ws + OFF_BAR), st);
#define MK_XB() XcdBarrier{(unsigned*)(p.ws + OFF_BAR), xb_xcc_id(), (volatile LAS unsigned*)((LAS char*)dyn_lds + LDS_PHASE)}
#if DIAG
  unsigned long long* TS = (unsigned long long*)(p.ws + OFF_TS);
  const bool rec = (blockIdx.x == 0 && threadIdx.x == 0);
  if (rec) TS[0] = wall_clock64();
#endif
  for (int ph = 0; ph < N_PHASES; ++ph) {
    run_phase(p, ph, dyn_lds);
#if DIAG
    if (ph == 0) grid.sync(); else xcd_barrier(MK_XB());
    if (rec) TS[ph + 1] = wall_clock64();
#else
    if (ph == 0) grid.sync(); else if (ph + 1 < N_PHASES) xcd_barrier(MK_XB());
#endif
  }
#if DIAG
  if (blockIdx.x == 0) {
    unsigned long long ta = 0, tb = 0;
    for (int ph = 0; ph < N_PHASES; ++ph) {
      const int type = ph == 0 ? 8 : (ph == N_PHASES - 1 ? 9 : ((ph - 1) & 7));
      const unsigned long long d = TS[ph + 1] - TS[ph];
      if ((DIAG_A >> type) & 1) ta += d;
      if ((DIAG_B >> type) & 1) tb += d;
    }
    const float vb = (float)tb * 0.01f * 0.00002f;
    (void)ta;
    for (int i = threadIdx.x; i < 4096; i += 512) p.out[i] += (i == 0) ? 0.f : vb;
  }
#endif
}
#if MK_MULTI
__global__ void __launch_bounds__(512, 2) phase_kernel(Params p, int ph) { run_phase(p, ph, dyn_lds); }
#endif

extern "C" void kernel_launch(void* const* d_in, const int* in_sizes, int n_in, void* d_out, int out_size, void* d_ws, size_t ws_size,
                              hipStream_t stream) {
  Params p{};
  const float** f = (const float**)&p;
  for (int i = 0; i < 23; ++i) f[i] = (const float*)d_in[i];
  p.out = (float*)d_out;
  p.ws = (char*)d_ws;
  if (ws_size < WS_TOTAL) { fprintf(stderr, "kernel_launch: ws too small: %zu < %zu\n", ws_size, (size_t)WS_NEED); return; }
  static int grid_blocks = 0;
  if (!grid_blocks) {
    (void)hipFuncSetAttribute((const void*)mega_kernel, hipFuncAttributeMaxDynamicSharedMemorySize, LDS_BYTES);
#if MK_MULTI
    (void)hipFuncSetAttribute((const void*)phase_kernel, hipFuncAttributeMaxDynamicSharedMemorySize, LDS_BYTES);
#endif
    int dev = 0, cus = 0, per_cu = 0;
    (void)hipGetDevice(&dev);
    (void)hipDeviceGetAttribute(&cus, hipDeviceAttributeMultiprocessorCount, dev);
    (void)hipOccupancyMaxActiveBlocksPerMultiprocessor(&per_cu, mega_kernel, 512, LDS_BYTES);
    if (per_cu > 1) per_cu = 1;
    if (per_cu < 1) per_cu = 1;
    grid_blocks = cus * per_cu;
  }
#if MK_MULTI
  for (int ph = 0; ph < N_PHASES; ++ph) hipLaunchKernelGGL(phase_kernel, dim3(grid_blocks), dim3(512), LDS_BYTES, stream, p, ph);
#else
  (void)hipMemsetAsync((char*)d_ws + OFF_BAR, 0, XCD_BAR_WORDS * 4, stream);
  void* args[] = {&p};
  hipError_t e = hipLaunchCooperativeKernel((void*)mega_kernel, dim3(grid_blocks), dim3(512), args, LDS_BYTES, stream);
  if (e != hipSuccess) fprintf(stderr, "cooperative launch failed: %s (grid %d)\n", hipGetErrorString(e), grid_blocks);
#endif
}
```
